# Optimizing an MI355X kernel written in HIP

```python
import jax, jax.numpy as jnp
from jax import lax
import numpy as np

D_MODEL = 1024
BATCH = 16
SEQ = 2048
DEPTH = 1

POOL_WIDTH = D_MODEL // 2
POOL_WINDOWS = (2, 4, 8, 16)
N_POOL_GROUPS = len(POOL_WINDOWS)
POOL_GROUP = POOL_WIDTH // N_POOL_GROUPS
SSD_HEAD_DIM = 64
SSD_INNER = D_MODEL
SSD_HEADS = SSD_INNER // SSD_HEAD_DIM
SSD_GROUPS = 2
SSD_HPG = SSD_HEADS // SSD_GROUPS
SSD_STATE = 128
CONV_WIDTH = 4
CHUNK = 128
CONV_CH = SSD_INNER + 2 * SSD_GROUPS * SSD_STATE
MIX_WIDTH = POOL_WIDTH + SSD_INNER
OFF_POOL = 0
OFF_Z = OFF_POOL + POOL_WIDTH
OFF_XBC = OFF_Z + SSD_INNER
OFF_DT = OFF_XBC + CONV_CH
IN_WIDTH = OFF_DT + SSD_HEADS
D_FF = 4 * D_MODEL
N_MOD = 6
EPS = 1e-5

kernel_name = "hybrid_pool_ssd_adaln_block"


def rms_norm(x, g):
    x32 = x.astype(jnp.float32)
    y = x32 * lax.rsqrt(jnp.mean(x32 * x32, axis=-1, keepdims=True) + EPS)
    return (y * g.astype(jnp.float32)).astype(x.dtype)


def pool_mixer(u, w_pool, pool_scale):
    Bsz, S, _ = u.shape
    u32 = u.astype(jnp.float32)
    cs = jnp.cumsum(u32, axis=1)
    t = jnp.arange(1, S + 1, dtype=jnp.float32)[None, :, None]
    outs = []
    for gi, w in enumerate(POOL_WINDOWS):
        sl = slice(gi * POOL_GROUP, (gi + 1) * POOL_GROUP)
        cs_g = cs[..., sl]
        prev = jnp.pad(cs_g, ((0, 0), (w, 0), (0, 0)))[:, :S]
        mean = (cs_g - prev) / jnp.minimum(t, float(w))
        outs.append(mean - u32[..., sl])
    p = jnp.stack(outs, axis=2).astype(u.dtype)
    y = jnp.einsum('bsgc,gcd->bsgd', p, w_pool).reshape(Bsz, S, POOL_WIDTH)
    return y * pool_scale


def causal_depthwise_conv(u, w, b):
    K = w.shape[0]
    S = u.shape[1]
    up = jnp.pad(u, ((0, 0), (K - 1, 0), (0, 0)))
    out = b + up[:, 0:S] * w[0]
    for k in range(1, K):
        out = out + up[:, k:k + S] * w[k]
    return out


def ssd_chunked(xs, dt, a, bm, cm):
    Bsz, S, G, R, P = xs.shape
    N = bm.shape[-1]
    nc = S // CHUNK
    xdt = (xs.astype(jnp.float32) * dt[..., None]).reshape(Bsz, nc, CHUNK, G, R, P)
    da = (dt * a).reshape(Bsz, nc, CHUNK, G, R)
    bc = bm.astype(jnp.float32).reshape(Bsz, nc, CHUNK, G, N)
    cc = cm.astype(jnp.float32).reshape(Bsz, nc, CHUNK, G, N)
    a_cum = jnp.cumsum(da, axis=2)
    causal = jnp.tril(jnp.ones((CHUNK, CHUNK), dtype=bool))[None, None, :, :, None, None]
    seg = a_cum[:, :, :, None] - a_cum[:, :, None, :]
    decay_in = jnp.exp(jnp.where(causal, seg, -jnp.inf))
    scores = jnp.einsum('bclgn,bcsgn->bclsg', cc, bc)
    y_diag = jnp.einsum('bclsgr,bcsgrp->bclgrp', scores[..., None] * decay_in, xdt)
    decay_out = jnp.exp(a_cum[:, :, -1:] - a_cum)
    states = jnp.einsum('bclgn,bclgr,bclgrp->bcgrpn', bc, decay_out, xdt)
    chunk_decay = jnp.exp(a_cum[:, :, -1])

    def step(h, inp):
        st, dec = inp
        return h * dec[..., None, None] + st, h

    h0 = jnp.zeros((Bsz, G, R, P, N), jnp.float32)
    _, prev = lax.scan(step, h0, (jnp.moveaxis(states, 1, 0), jnp.moveaxis(chunk_decay, 1, 0)))
    prev = jnp.moveaxis(prev, 0, 1)
    y_off = jnp.einsum('bclgn,bcgrpn,bclgr->bclgrp', cc, prev, jnp.exp(a_cum))
    return (y_diag + y_off).reshape(Bsz, S, G, R, P)


def ssd_mixer(z, u_xbc, u_dt, conv_w, conv_b, dt_bias, a_log, d_skip, g_ssd):
    Bsz, S, _ = z.shape
    xbc = jax.nn.silu(causal_depthwise_conv(u_xbc, conv_w, conv_b))
    GN = SSD_GROUPS * SSD_STATE
    xs = xbc[..., :SSD_INNER].reshape(Bsz, S, SSD_GROUPS, SSD_HPG, SSD_HEAD_DIM)
    bm = xbc[..., SSD_INNER:SSD_INNER + GN].reshape(Bsz, S, SSD_GROUPS, SSD_STATE)
    cm = xbc[..., SSD_INNER + GN:].reshape(Bsz, S, SSD_GROUPS, SSD_STATE)
    dt = jax.nn.softplus(u_dt.astype(jnp.float32) + dt_bias.astype(jnp.float32))
    dt = dt.reshape(Bsz, S, SSD_GROUPS, SSD_HPG)
    a = -jnp.exp(a_log.astype(jnp.float32)).reshape(SSD_GROUPS, SSD_HPG)
    y = ssd_chunked(xs, dt, a, bm, cm)
    y = y + d_skip.astype(jnp.float32).reshape(SSD_GROUPS, SSD_HPG)[:, :, None] * xs.astype(jnp.float32)
    y = y.reshape(Bsz, S, SSD_INNER) * jax.nn.silu(z.astype(jnp.float32))
    yg = y.reshape(Bsz, S, SSD_GROUPS, SSD_INNER // SSD_GROUPS)
    yg = yg * lax.rsqrt(jnp.mean(yg * yg, axis=-1, keepdims=True) + EPS)
    y = yg.reshape(Bsz, S, SSD_INNER) * g_ssd.astype(jnp.float32)
    return y.astype(z.dtype)


def setup_inputs(seed: int = 0) -> dict:
    key = jax.random.key(seed)
    ks = jax.random.split(key, 20)
    f32 = jnp.float32
    L = DEPTH
    x = jax.random.normal(ks[0], (BATCH, SEQ, D_MODEL), f32)
    c = jax.random.normal(ks[1], (BATCH, D_MODEL), f32)
    w_ada = jax.random.normal(ks[2], (L, D_MODEL, N_MOD * D_MODEL), f32) * D_MODEL ** -0.5
    b_ada = jax.random.normal(ks[3], (L, N_MOD * D_MODEL), f32) * 0.02
    g_mix = 1.0 + 0.02 * jax.random.normal(ks[4], (L, D_MODEL), f32)
    w_in = jax.random.normal(ks[5], (L, D_MODEL, IN_WIDTH), f32) * D_MODEL ** -0.5
    conv_w = jax.random.normal(ks[6], (L, CONV_WIDTH, CONV_CH), f32) * CONV_WIDTH ** -0.5
    conv_b = jax.random.normal(ks[7], (L, CONV_CH), f32) * 0.02
    dt0 = jnp.exp(jax.random.uniform(ks[8], (L, SSD_HEADS), f32, np.log(1e-3), np.log(1e-1)))
    dt_bias = dt0 + jnp.log(-jnp.expm1(-dt0))
    a_log = jnp.log(jax.random.uniform(ks[9], (L, SSD_HEADS), f32, 1.0, 16.0))
    d_skip = 1.0 + 0.1 * jax.random.normal(ks[10], (L, SSD_HEADS), f32)
    g_ssd = 1.0 + 0.02 * jax.random.normal(ks[11], (L, SSD_INNER), f32)
    w_pool = jax.random.normal(ks[12], (L, N_POOL_GROUPS, POOL_GROUP, POOL_GROUP), f32) * POOL_GROUP ** -0.5
    pool_scale = 1.0 + 0.1 * jax.random.normal(ks[13], (L, POOL_WIDTH), f32)
    w_out = jax.random.normal(ks[14], (L, MIX_WIDTH, D_MODEL), f32) * MIX_WIDTH ** -0.5
    g_mlp = 1.0 + 0.02 * jax.random.normal(ks[15], (L, D_MODEL), f32)
    w_up = jax.random.normal(ks[16], (L, D_MODEL, D_FF), f32) * D_MODEL ** -0.5
    w_down = jax.random.normal(ks[17], (L, D_FF, D_MODEL), f32) * D_FF ** -0.5
    g_final = 1.0 + 0.02 * jax.random.normal(ks[18], (D_MODEL,), f32)
    return {"x": x, "c": c, "w_ada": w_ada, "b_ada": b_ada, "g_mix": g_mix, "w_in": w_in,
            "conv_w": conv_w, "conv_b": conv_b, "dt_bias": dt_bias, "a_log": a_log,
            "d_skip": d_skip, "g_ssd": g_ssd, "w_pool": w_pool, "pool_scale": pool_scale,
            "w_out": w_out, "g_mlp": g_mlp, "w_up": w_up, "w_down": w_down, "g_final": g_final}


def reference(x, c, w_ada, b_ada, g_mix, w_in, conv_w, conv_b, dt_bias, a_log, d_skip, g_ssd,
              w_pool, pool_scale, w_out, g_mlp, w_up, w_down, g_final):
    h = x
    c_act = jax.nn.silu(c)
    for layer in range(DEPTH):
        mod = jnp.einsum('bd,de->be', c_act, w_ada[layer]) + b_ada[layer]
        shift_m, scale_m, gate_m, shift_f, scale_f, gate_f = jnp.split(mod[:, None, :], N_MOD, axis=-1)

        u = rms_norm(h, g_mix[layer]) * (1.0 + scale_m) + shift_m
        proj = jnp.einsum('bsd,de->bse', u, w_in[layer])
        u_pool = proj[..., OFF_POOL:OFF_Z]
        z = proj[..., OFF_Z:OFF_XBC]
        u_xbc = proj[..., OFF_XBC:OFF_DT]
        u_dt = proj[..., OFF_DT:]
        y_pool = pool_mixer(u_pool, w_pool[layer], pool_scale[layer])
        y_ssd = ssd_mixer(z, u_xbc, u_dt, conv_w[layer], conv_b[layer], dt_bias[layer],
                          a_log[layer], d_skip[layer], g_ssd[layer])
        y_mix = jnp.concatenate([y_pool.astype(h.dtype), y_ssd.astype(h.dtype)], axis=-1)
        h = h + gate_m * jnp.einsum('bse,ed->bsd', y_mix, w_out[layer])

        u = rms_norm(h, g_mlp[layer]) * (1.0 + scale_f) + shift_f
        f = jnp.square(jax.nn.relu(jnp.einsum('bsd,df->bsf', u, w_up[layer])))
        h = h + gate_f * jnp.einsum('bsf,fd->bsd', f, w_down[layer])
    return rms_norm(h, g_final)
```

```cpp
#include <hip/hip_runtime.h>
#include <hip/hip_cooperative_groups.h>
#include <cstdio>
#include <cstdint>
namespace cg = cooperative_groups;
namespace pg8 {
#define PG8_LAS __attribute__((address_space(3)))
typedef unsigned short bf16_t;
typedef short bf16x8 __attribute__((ext_vector_type(8)));
typedef float f32x4 __attribute__((ext_vector_type(4)));
typedef unsigned u32x4 __attribute__((ext_vector_type(4)));
constexpr int BM = 256, BK = 64, HALF = 128, HTB = HALF * BK * 2  , STAGE_BYTES = 8 * HTB, NXCD = 8, WGM = 8;

__host__ __device__ __forceinline__ int lds_byte(int r, int c) { const int st = (r >> 4) * 2 + (c >> 5), rr = r & 15, cc = c & 31, ob = rr * 64 + cc * 2; return st * 1024 + (ob ^ (((ob >> 9) & 1) << 5)); }
__host__ __device__ __forceinline__ void stage_rc(int b, int& R, int& C) { const int st = b / 1024, sb = b % 1024, swz = sb ^ (((sb >> 9) & 1) << 5); R = (st >> 1) * 16 + swz / 64; C = (st & 1) * 32 + (swz % 64) / 2; }
__host__ __device__ __forceinline__ int perm32(int rho) { const int n = rho >> 4, i = rho & 15; return 8 * (i >> 2) + 4 * n + (i & 3); }

struct Unit { int pm, pn; };
struct Gemm { const bf16_t* A; const bf16_t* Bt; int M, N, K; };

struct StaticOrder {
    int nM, nN, nwg, G, c;
    __host__ __device__ void init(int M, int N, int G_, int c_) { nM = M / BM; nN = N / BM; nwg = nM * nN; G = G_; c = c_; }
    __host__ __device__ bool next(int i, Unit& u) const {
        const long L = (long)i * G + c; if (L >= nwg) return false;
        int wgid = (int)L; { const int q = nwg / NXCD, r = nwg % NXCD, xcd = wgid % NXCD, off = wgid / NXCD; wgid = (xcd < r ? xcd * (q + 1) : r * (q + 1) + (xcd - r) * q) + off; }
        const int nig = WGM * nN, gid = wgid / nig, fm = gid * WGM, gsz = (nM - fm) < WGM ? (nM - fm) : WGM;
        u.pm = fm + ((wgid % nig) % gsz); u.pn = (wgid % nig) / gsz; return true;
    }
    __device__ __forceinline__ void a_ready(const Unit&) const {}
    __device__ __forceinline__ void done(const Unit&) const {}
};

__device__ __forceinline__ unsigned cvt_pk_bf16(float lo, float hi) { unsigned r; asm volatile("v_cvt_pk_bf16_f32 %0, %1, %2" : "=v"(r) : "v"(lo), "v"(hi)); return r; }
typedef float f32x2 __attribute__((ext_vector_type(2)));
template <int ACT  > struct EpiBf16 {
    static constexpr bool PERM = true, AFTER_DRAIN = false;
    bf16_t* O; int ldc;
    __device__ __forceinline__ void operator()(const f32x4 (&acc)[2][2][4][2], const Unit& u, int wr, int wc, int fr, int fq) const {
        const int row0 = u.pm * BM + wr * 64 + fr; const int col0 = u.pn * BM + wc * 32 + 8 * fq;
#pragma unroll
        for (int ai = 0; ai < 2; ++ai)
#pragma unroll
            for (int m = 0; m < 4; ++m) { bf16_t* rowp = O + (size_t)(row0 + ai * HALF + m * 16) * ldc + col0;
#pragma unroll
                for (int bj = 0; bj < 2; ++bj) { f32x4 v0 = acc[ai][bj][m][0], v1 = acc[ai][bj][m][1];
                    if (ACT == 2) {
#pragma unroll
                        for (int j = 0; j < 4; ++j) { const float a = fmaxf(v0[j], 0.f), b = fmaxf(v1[j], 0.f); v0[j] = a * a; v1[j] = b * b; } }
                    u32x4 w; w.x = cvt_pk_bf16(v0[0], v0[1]); w.y = cvt_pk_bf16(v0[2], v0[3]); w.z = cvt_pk_bf16(v1[0], v1[1]); w.w = cvt_pk_bf16(v1[2], v1[3]);
                    *(u32x4*)(rowp + bj * HALF) = w; } }
    }
};
struct EpiResGate {
    static constexpr bool PERM = false, AFTER_DRAIN = false;
    const float* base; float* out; const float* gate; int rows_per_batch, gate_stride;
    __device__ __forceinline__ void operator()(const f32x4 (&acc)[2][2][4][2], const Unit& u, int wr, int wc, int fr, int fq) const {
        const int row0 = u.pm * BM + wr * 64 + fr, col0 = u.pn * BM + wc * 32 + 4 * fq;
        const float* gp = gate + (size_t)((u.pm * BM) / rows_per_batch) * gate_stride + col0;
        f32x4 gv[2][2];
#pragma unroll
        for (int bj = 0; bj < 2; ++bj)
#pragma unroll
            for (int n = 0; n < 2; ++n) gv[bj][n] = *(const f32x4*)(gp + bj * HALF + n * 16);
#pragma unroll
        for (int ai = 0; ai < 2; ++ai)
#pragma unroll
            for (int m = 0; m < 4; ++m) { const size_t off = (size_t)(row0 + ai * HALF + m * 16) * 1024 + col0;
#pragma unroll
                for (int bj = 0; bj < 2; ++bj)
#pragma unroll
                    for (int n = 0; n < 2; ++n) { const f32x4 bs = *(const f32x4*)(base + off + bj * HALF + n * 16); *(f32x4*)(out + off + bj * HALF + n * 16) = bs + gv[bj][n] * acc[ai][bj][m][n]; }
                asm volatile("" ::: "memory"); }
    }
};
template <class Epi, class Sched, bool ALIGN_EPI = false, bool SP2 = false>
__device__ __forceinline__ void gemm_phase(PG8_LAS unsigned char* lds, const Gemm g, const Sched& S, const Epi& E) {
    const int tid = threadIdx.x, wid = __builtin_amdgcn_readfirstlane(tid >> 6), lane = tid & 63, wr = wid >> 2, wc = wid & 3, fr = lane & 15, fq = lane >> 4;
    const int K = g.K, nt = K / BK;
    unsigned voffA[2], voffB[2];
#pragma unroll
    for (int i = 0; i < 2; ++i) { int R, C; stage_rc(tid * 16 + i * 8192, R, C); const int Rb = Epi::PERM ? ((R & ~31) + perm32(R & 31)) : R;
        voffA[i] = (unsigned)(R * K + C) * 2u; voffB[i] = (unsigned)(Rb * K + C) * 2u; }
    const size_t kstep = (size_t)(BK * 2);
    const size_t hstep = (size_t)HALF * K * 2;
    const size_t tstep = 2 * hstep;
    const unsigned ldsw = (unsigned)wid * 1024u;
    const int aoff = lds_byte(wr * 64 + fr, fq * 8), boff = lds_byte(wc * 32 + fr, fq * 8);
#define PG8_SA(b, h) (((b) * 2 + (h)) * HTB)
#define PG8_SB(b, h) ((4 + (b) * 2 + (h)) * HTB)
#define PG8_STAGE(bufoff, gbase, voff) do { _Pragma("unroll") for (int _i = 0; _i < 2; ++_i) \
        __builtin_amdgcn_global_load_lds((const unsigned*)((const char*)(gbase) + (voff)[_i]), (PG8_LAS unsigned*)(lds + (bufoff) + ldsw + _i * 8192), 16, 0, 0); } while (0)
#define PG8_LDA(dst, b, h) do { _Pragma("unroll") for (int m = 0; m < 4; ++m) _Pragma("unroll") for (int k = 0; k < 2; ++k) dst[m][k] = *(const PG8_LAS bf16x8*)(lds + PG8_SA(b, h) + aoff + m * 2048 + k * 1024); } while (0)
#define PG8_LDB(dst, b, h) do { _Pragma("unroll") for (int n = 0; n < 2; ++n) _Pragma("unroll") for (int k = 0; k < 2; ++k) dst[n][k] = *(const PG8_LAS bf16x8*)(lds + PG8_SB(b, h) + boff + n * 2048 + k * 1024); } while (0)
#define PG8_MMA(ai, bj, At, Bt) do { __builtin_amdgcn_s_setprio(1); _Pragma("unroll") for (int m = 0; m < 4; ++m) _Pragma("unroll") for (int n = 0; n < 2; ++n) _Pragma("unroll") for (int k = 0; k < 2; ++k) \
        acc[ai][bj][m][n] = __builtin_amdgcn_mfma_f32_16x16x32_bf16(Bt[n][k], At[m][k], acc[ai][bj][m][n], 0, 0, 0); __builtin_amdgcn_s_setprio(0); } while (0)
#define PG8_WAIT_V(n) asm volatile("s_waitcnt vmcnt(" #n ")" ::: "memory")
#define PG8_WAIT_L(n) asm volatile("s_waitcnt lgkmcnt(" #n ")" ::: "memory")
#define PG8_BAR __builtin_amdgcn_s_barrier()
#define PG8_SCHED __builtin_amdgcn_sched_barrier(0)
    Unit cur, nxt; int ui = 0;
    if (!S.next(0, cur)) return;
    f32x4 acc[2][2][4][2];
#pragma unroll
    for (int a = 0; a < 2; ++a)
#pragma unroll
        for (int b = 0; b < 2; ++b)
#pragma unroll
            for (int m = 0; m < 4; ++m)
#pragma unroll
                for (int n = 0; n < 2; ++n) acc[a][b][m][n] = (f32x4){0.f, 0.f, 0.f, 0.f};
    bf16x8 At[4][2], B0[2][2], B1[2][2];
    const char* cA = (const char*)g.A + (size_t)cur.pm * tstep; const char* cB = (const char*)g.Bt + (size_t)cur.pn * tstep;
    S.a_ready(cur);
    if constexpr (SP2) {
        PG8_STAGE(PG8_SB(0, 0), cB, voffB); PG8_STAGE(PG8_SB(0, 1), cB + hstep, voffB); PG8_STAGE(PG8_SA(0, 0), cA, voffA); PG8_STAGE(PG8_SA(0, 1), cA + hstep, voffA);
        if (wr == 1) PG8_BAR;
        PG8_WAIT_V(2); PG8_BAR;
        PG8_STAGE(PG8_SB(1, 0), cB + kstep, voffB); PG8_STAGE(PG8_SA(1, 0), cA + kstep, voffA); PG8_STAGE(PG8_SB(1, 1), cB + hstep + kstep, voffB);
        PG8_WAIT_V(6); PG8_BAR;
    } else {
        PG8_STAGE(PG8_SB(0, 0), cB, voffB); PG8_STAGE(PG8_SA(0, 0), cA, voffA); PG8_STAGE(PG8_SB(0, 1), cB + hstep, voffB); PG8_STAGE(PG8_SA(0, 1), cA + hstep, voffA);
        if (wr == 1) PG8_BAR;
        PG8_WAIT_V(4); PG8_BAR;
        PG8_STAGE(PG8_SB(1, 0), cB + kstep, voffB); PG8_STAGE(PG8_SA(1, 0), cA + kstep, voffA); PG8_STAGE(PG8_SB(1, 1), cB + hstep + kstep, voffB);
        PG8_WAIT_V(6); PG8_BAR;
    }
    for (;;) {
        const bool has_next = S.next(ui + 1, nxt);
        const char* nA = has_next ? (const char*)g.A + (size_t)nxt.pm * tstep : cA; const char* nB = has_next ? (const char*)g.Bt + (size_t)nxt.pn * tstep : cB;
        for (int t = 0; t < nt; t += 2) {
            const bool last = (t == nt - 2);
            const char* a1 = cA + (size_t)(t + 1) * kstep;
            const char* a2 = last ? nA : cA + (size_t)(t + 2) * kstep; const char* b2 = last ? nB : cB + (size_t)(t + 2) * kstep;
            const char* a3 = a2 + kstep; const char* b3 = b2 + kstep;
            if (last && has_next) S.a_ready(nxt);
            if constexpr (SP2) {
            PG8_LDB(B0, 0, 0); PG8_LDB(B1, 0, 1); PG8_SCHED; PG8_LDA(At, 0, 0); PG8_STAGE(PG8_SA(1, 1), a1 + hstep, voffA);
            PG8_WAIT_V(8); PG8_WAIT_L(0); PG8_BAR; PG8_MMA(0, 0, At, B0); PG8_MMA(0, 1, At, B1); PG8_BAR; PG8_SCHED;
            PG8_LDA(At, 0, 1); PG8_STAGE(PG8_SB(0, 0), b2, voffB); PG8_STAGE(PG8_SB(0, 1), b2 + hstep, voffB); PG8_STAGE(PG8_SA(0, 0), a2, voffA);
            PG8_WAIT_V(8); PG8_WAIT_L(0); PG8_BAR; PG8_MMA(1, 0, At, B0); PG8_MMA(1, 1, At, B1); PG8_BAR; PG8_SCHED;
            PG8_LDB(B0, 1, 0); PG8_LDB(B1, 1, 1); PG8_SCHED; PG8_LDA(At, 1, 0); PG8_STAGE(PG8_SA(0, 1), a2 + hstep, voffA);
            PG8_WAIT_V(8); PG8_WAIT_L(0); PG8_BAR; PG8_MMA(0, 0, At, B0); PG8_MMA(0, 1, At, B1); PG8_BAR; PG8_SCHED;
            PG8_LDA(At, 1, 1); PG8_STAGE(PG8_SB(1, 0), b3, voffB); PG8_STAGE(PG8_SB(1, 1), b3 + hstep, voffB); PG8_STAGE(PG8_SA(1, 0), a3, voffA);
            PG8_WAIT_V(8); PG8_WAIT_L(0); PG8_BAR; PG8_MMA(1, 0, At, B0); PG8_MMA(1, 1, At, B1); PG8_BAR; PG8_SCHED;
            } else {
            PG8_LDB(B0, 0, 0); PG8_SCHED; PG8_LDA(At, 0, 0); PG8_STAGE(PG8_SA(1, 1), a1 + hstep, voffA);
            PG8_WAIT_L(8); PG8_BAR; PG8_WAIT_L(0); PG8_MMA(0, 0, At, B0); PG8_BAR; PG8_SCHED;
            PG8_LDB(B1, 0, 1); PG8_STAGE(PG8_SB(0, 0), b2, voffB);
            PG8_BAR; PG8_WAIT_L(0); PG8_MMA(0, 1, At, B1); PG8_BAR;
            PG8_LDA(At, 0, 1); PG8_STAGE(PG8_SA(0, 0), a2, voffA);
            PG8_BAR; PG8_WAIT_L(0); PG8_MMA(1, 0, At, B0); PG8_BAR; PG8_SCHED;
            PG8_STAGE(PG8_SB(0, 1), b2 + hstep, voffB);
            PG8_WAIT_V(6); PG8_BAR; PG8_MMA(1, 1, At, B1); PG8_BAR;
            PG8_LDB(B0, 1, 0); PG8_SCHED; PG8_LDA(At, 1, 0); PG8_STAGE(PG8_SA(0, 1), a2 + hstep, voffA);
            PG8_WAIT_L(8); PG8_BAR; PG8_WAIT_L(0); PG8_MMA(0, 0, At, B0); PG8_BAR; PG8_SCHED;
            PG8_LDB(B1, 1, 1); PG8_STAGE(PG8_SB(1, 0), b3, voffB);
            PG8_BAR; PG8_WAIT_L(0); PG8_MMA(0, 1, At, B1); PG8_BAR;
            PG8_LDA(At, 1, 1); PG8_STAGE(PG8_SA(1, 0), a3, voffA);
            PG8_BAR; PG8_WAIT_L(0); PG8_MMA(1, 0, At, B0); PG8_BAR; PG8_SCHED;
            PG8_STAGE(PG8_SB(1, 1), b3 + hstep, voffB);
            PG8_WAIT_V(6); PG8_BAR; PG8_MMA(1, 1, At, B1); PG8_BAR;
            }
        }
        if constexpr (ALIGN_EPI) { if (wr == 0) PG8_BAR; }
        if constexpr (!Epi::AFTER_DRAIN) { E(acc, cur, wr, wc, fr, fq); S.done(cur); }
        if (!has_next) break;
#pragma unroll
        for (int a = 0; a < 2; ++a)
#pragma unroll
            for (int b = 0; b < 2; ++b)
#pragma unroll
                for (int m = 0; m < 4; ++m)
#pragma unroll
                    for (int n = 0; n < 2; ++n) acc[a][b][m][n] = (f32x4){0.f, 0.f, 0.f, 0.f};
        cur = nxt; cA = nA; cB = nB; ++ui;
        if constexpr (ALIGN_EPI) { if (wr == 1) PG8_BAR; }
    }
    PG8_WAIT_V(0);
    if constexpr (!ALIGN_EPI) { if (wr == 0) PG8_BAR; }
    PG8_BAR;
    if constexpr (Epi::AFTER_DRAIN) { E.fused(acc, cur, wr, wc, fr, fq, lds, wid, lane); S.done(cur); }
#undef PG8_SA
#undef PG8_SB
#undef PG8_STAGE
#undef PG8_LDA
#undef PG8_LDB
#undef PG8_MMA
#undef PG8_WAIT_V
#undef PG8_WAIT_L
#undef PG8_BAR
#undef PG8_SCHED
}
}
#define LAS __attribute__((address_space(3)))
typedef unsigned short bf16;
typedef unsigned v4u __attribute__((ext_vector_type(4)));
typedef unsigned v2u __attribute__((ext_vector_type(2)));
typedef float f32x4 __attribute__((ext_vector_type(4)));
constexpr int D = 1024, BATCH = 16, SEQ = 2048, M = BATCH * SEQ;
constexpr int NHEADS = 16, HD = 64, NST = 128, CONVCH = 1536, MIXW = 1536, INW = 3088, NPROJ = 3072, FF = 4096, NMOD = 6 * D;
constexpr float EPS = 1e-5f;
constexpr int NWAVES = 8, NTHR = 512;
constexpr int LDS_BYTES = 147456;
constexpr size_t MiB = 1u << 20;
constexpr size_t WS_MOD = 0, WS_DT = 2 * MiB, WS_SSQ = 4 * MiB, WS_WIN = 6 * MiB, WS_WOUT = 12 * MiB, WS_WUP = 16 * MiB, WS_WDN = 24 * MiB;
constexpr size_t WS_XN = 32 * MiB, WS_PROJ = 96 * MiB, WS_CONV = 288 * MiB, WS_YMIX = 384 * MiB, WS_F = 96 * MiB, WS_END = 480 * MiB;

__device__ __forceinline__ unsigned f2bf(float f) { unsigned u = __float_as_uint(f); return (u + 0x7fffu + ((u >> 16) & 1u)) >> 16; }
__device__ __forceinline__ unsigned pk2(float lo, float hi) { return f2bf(lo) | (f2bf(hi) << 16); }
__device__ __forceinline__ float bflo(unsigned w) { return __uint_as_float(w << 16); }
__device__ __forceinline__ float bfhi(unsigned w) { return __uint_as_float(w & 0xffff0000u); }
__device__ __forceinline__ void unpack8(const v4u w, float (&f)[8]) { f[0] = bflo(w.x); f[1] = bfhi(w.x); f[2] = bflo(w.y); f[3] = bfhi(w.y); f[4] = bflo(w.z); f[5] = bfhi(w.z); f[6] = bflo(w.w); f[7] = bfhi(w.w); }
__device__ __forceinline__ v4u pack8(const float (&f)[8]) { v4u w; w.x = pk2(f[0], f[1]); w.y = pk2(f[2], f[3]); w.z = pk2(f[4], f[5]); w.w = pk2(f[6], f[7]); return w; }
__device__ __forceinline__ float wave_sum(float v) {
#pragma unroll
    for (int o = 1; o < 64; o <<= 1) v += __shfl_xor(v, o);
    return v;
}
__device__ __forceinline__ float silu_f(float v) { return v / (1.f + __expf(-v)); }
__device__ __forceinline__ float softplus_f(float v) { return fmaxf(v, 0.f) + log1pf(__expf(-fabsf(v))); }

struct Args { const float* in[19]; float* out; unsigned char* ws; int ph_lo, ph_hi; };

__device__ __forceinline__ void transpose_item(const float* W, int ldw, int col0, int K, bf16* WT, int row_off, LAS float* scr, int kb, int nb, int lane) {
    const int k0 = 64 * kb, n0 = 32 * nb;
#pragma unroll 8
    for (int i = 0; i < 32; ++i) { const int kk = 2 * i + (lane >> 5); scr[kk * 33 + (lane & 31)] = W[(size_t)(k0 + kk) * ldw + col0 + n0 + (lane & 31)]; }
    asm volatile("s_waitcnt lgkmcnt(0)" ::: "memory");
    const int c = lane & 7;
#pragma unroll
    for (int j = 0; j < 4; ++j) { const int n = (lane >> 3) + 8 * j; const LAS float* s = scr + (8 * c) * 33 + n;
        v4u o; o.x = pk2(s[0 * 33], s[1 * 33]); o.y = pk2(s[2 * 33], s[3 * 33]); o.z = pk2(s[4 * 33], s[5 * 33]); o.w = pk2(s[6 * 33], s[7 * 33]);
        *(v4u*)(WT + (size_t)(row_off + n0 + n) * K + k0 + 8 * c) = o; }
    asm volatile("s_waitcnt lgkmcnt(0)" ::: "memory");
}

__device__ __forceinline__ void p0_prologue(LAS unsigned char* lds, const Args& a, int G) {
    const int tid = threadIdx.x, lane = tid & 63, wave = tid >> 6;
    unsigned char* ws = a.ws;
    const float* w_in = a.in[5];
    bf16* WtIn = (bf16*)(ws + WS_WIN);
    {
        LAS float* wp = (LAS float*)lds;
        LAS float* win = (LAS float*)(lds + 65536);
        for (int it = blockIdx.x; it < 256; it += G) {
            const int g = it >> 6, k0 = (it & 63) * 16;
            const float* wpg = a.in[12] + (size_t)g * 16384;
            for (int i = tid; i < 16384; i += NTHR) wp[i] = wpg[i];
            for (int i = tid; i < 2048; i += NTHR) { const int kk = i >> 7, c = i & 127; win[i] = w_in[(size_t)(k0 + kk) * INW + g * 128 + c]; }
            __syncthreads();
            const int kk = tid >> 5, d4 = (tid & 31) * 4;
            f32x4 acc = {0.f, 0.f, 0.f, 0.f};
#pragma unroll 8
            for (int c = 0; c < 128; ++c) { const float av = win[kk * 128 + c]; const f32x4 w4 = *(const LAS f32x4*)(wp + c * 128 + d4); acc += av * w4; }
#pragma unroll
            for (int e = 0; e < 4; ++e) WtIn[(size_t)(g * 128 + d4 + e) * D + k0 + kk] = (bf16)f2bf(acc[e]);
            __syncthreads();
        }
    }
    {
        LAS float* cst = (LAS float*)lds;
        LAS float* part = (LAS float*)(lds + 65536);
        const float* cin = a.in[1]; const float* w_ada = a.in[2]; const float* b_ada = a.in[3];
        float* MOD = (float*)(ws + WS_MOD);
        if ((int)blockIdx.x < 192) {
            for (int i = tid; i < 16384; i += NTHR) { const int b = i >> 10, k = i & 1023; cst[k * 16 + b] = silu_f(cin[i]); }
            __syncthreads();
        }
        for (int it = blockIdx.x; it < 192; it += G) {
            const int col0 = it * 32, kh = lane >> 5, col = lane & 31, kbase = wave * 128 + kh * 64;
            float acc[16];
#pragma unroll
            for (int b = 0; b < 16; ++b) acc[b] = 0.f;
#pragma unroll 8
            for (int i = 0; i < 64; ++i) {
                const int k = kbase + i; const float wv = w_ada[(size_t)k * NMOD + col0 + col];
#pragma unroll
                for (int q = 0; q < 4; ++q) { const f32x4 c4 = *(const LAS f32x4*)(cst + k * 16 + 4 * q); acc[4 * q + 0] += c4.x * wv; acc[4 * q + 1] += c4.y * wv; acc[4 * q + 2] += c4.z * wv; acc[4 * q + 3] += c4.w * wv; }
            }
#pragma unroll
            for (int b = 0; b < 16; ++b) part[((wave * 2 + kh) * 16 + b) * 32 + col] = acc[b];
            __syncthreads();
            { const int b = tid >> 5, cc = tid & 31; float s = b_ada[col0 + cc];
#pragma unroll
              for (int p = 0; p < 16; ++p) s += part[(p * 16 + b) * 32 + cc];
              MOD[(size_t)b * NMOD + col0 + cc] = s; }
            __syncthreads();
        }
    }
    __syncthreads();
    {
        LAS float* scr = (LAS float*)(lds + wave * 16384);
        const int gw = blockIdx.x * NWAVES + wave, NGW = G * NWAVES;
        constexpr int I_IN = 16 * 80, I_OUT = 24 * 32, I_UP = 16 * 128, I_DN = 64 * 32;
        for (int it = gw; it < I_IN + I_OUT + I_UP + I_DN; it += NGW) {
            int r = it;
            if (r < I_IN) { transpose_item(w_in, INW, 512, D, WtIn, 512, scr, r / 80, r % 80, lane); continue; } r -= I_IN;
            if (r < I_OUT) { transpose_item(a.in[14], D, 0, MIXW, (bf16*)(ws + WS_WOUT), 0, scr, r / 32, r % 32, lane); continue; } r -= I_OUT;
            if (r < I_UP) { transpose_item(a.in[16], FF, 0, D, (bf16*)(ws + WS_WUP), 0, scr, r / 128, r % 128, lane); continue; } r -= I_UP;
            transpose_item(a.in[17], D, 0, FF, (bf16*)(ws + WS_WDN), 0, scr, r / 32, r % 32, lane);
        }
    }
}

template <bool WITH_DT>
__device__ __forceinline__ void normmod_phase(LAS unsigned char* lds, const float* src, const float* gvec, const float* MOD, int shift_ofs, int scale_ofs, bf16* XN,
                                              const float* w_in, const float* dt_bias, float* DT, int G) {
    const int tid = threadIdx.x, lane = tid & 63, wave = tid >> 6;
    LAS float* WdtL = (LAS float*)lds;
    if (WITH_DT) {
        for (int i = tid; i < 16384; i += NTHR) { const int k = i >> 4, h = i & 15; WdtL[h * 1024 + k] = w_in[(size_t)k * INW + NPROJ + h]; }
        __syncthreads();
    }
    const int gw = blockIdx.x * NWAVES + wave, NGW = G * NWAVES;
    for (int rg = gw; rg < M / 16; rg += NGW) {
        const int m0 = rg * 16, b = m0 / SEQ;
        const float* mp = MOD + (size_t)b * NMOD;
        f32x4 gs[4], sh[4];
#pragma unroll
        for (int j = 0; j < 4; ++j) { const int k = 4 * lane + 256 * j; const f32x4 g4 = *(const f32x4*)(gvec + k); const f32x4 sc = *(const f32x4*)(mp + scale_ofs + k); gs[j] = g4 * (sc + 1.0f); sh[j] = *(const f32x4*)(mp + shift_ofs + k); }
        for (int r = 0; r < 16; ++r) {
            const int m = m0 + r;
            const f32x4* xr = (const f32x4*)(src + (size_t)m * D) + lane;
            f32x4 v[4]; float ss = 0.f;
#pragma unroll
            for (int j = 0; j < 4; ++j) { v[j] = xr[64 * j]; ss += (v[j].x * v[j].x + v[j].y * v[j].y) + (v[j].z * v[j].z + v[j].w * v[j].w); }
            ss = wave_sum(ss);
            const float rinv = 1.0f / sqrtf(ss * (1.0f / D) + EPS);
#pragma unroll
            for (int j = 0; j < 4; ++j) v[j] = v[j] * rinv * gs[j] + sh[j];
            unsigned long long* o8 = (unsigned long long*)(XN + (size_t)m * D) + lane;
#pragma unroll
            for (int j = 0; j < 4; ++j) o8[64 * j] = (unsigned long long)pk2(v[j].x, v[j].y) | ((unsigned long long)pk2(v[j].z, v[j].w) << 32);
            if (WITH_DT) {
                float acc[16];
#pragma unroll
                for (int h = 0; h < 16; ++h) { float s = 0.f;
#pragma unroll
                    for (int j = 0; j < 4; ++j) { const f32x4 w4 = *(const LAS f32x4*)(WdtL + h * 1024 + 4 * lane + 256 * j); s += (v[j].x * w4.x + v[j].y * w4.y) + (v[j].z * w4.z + v[j].w * w4.w); }
                    acc[h] = s; if ((h & 3) == 3) asm volatile("" ::: "memory"); }
                float a8[8], a4[4], a2[2], a1;
                const bool u5 = (lane & 32) != 0, u4 = (lane & 16) != 0, u3 = (lane & 8) != 0, u2 = (lane & 4) != 0;
#pragma unroll
                for (int i = 0; i < 8; ++i) { const float keep = u5 ? acc[i + 8] : acc[i], send = u5 ? acc[i] : acc[i + 8]; a8[i] = keep + __shfl_xor(send, 32); }
#pragma unroll
                for (int i = 0; i < 4; ++i) { const float keep = u4 ? a8[i + 4] : a8[i], send = u4 ? a8[i] : a8[i + 4]; a4[i] = keep + __shfl_xor(send, 16); }
#pragma unroll
                for (int i = 0; i < 2; ++i) { const float keep = u3 ? a4[i + 2] : a4[i], send = u3 ? a4[i] : a4[i + 2]; a2[i] = keep + __shfl_xor(send, 8); }
                { const float keep = u2 ? a2[1] : a2[0], send = u2 ? a2[0] : a2[1]; a1 = keep + __shfl_xor(send, 4); }
                a1 += __shfl_xor(a1, 2); a1 += __shfl_xor(a1, 1);
                const int h = ((lane >> 5) & 1) * 8 + ((lane >> 4) & 1) * 4 + ((lane >> 3) & 1) * 2 + ((lane >> 2) & 1);
                if ((lane & 3) == 0) DT[(size_t)m * 16 + h] = softplus_f(a1 + dt_bias[h]);
            }
        }
    }
}

__device__ __forceinline__ void halo_phase(const Args& a, int G) {
    const int tid = threadIdx.x, cgp = tid & 255, rsub = tid >> 8;
    const bf16* PROJ = (const bf16*)(a.ws + WS_PROJ);
    bf16* YMIX = (bf16*)(a.ws + WS_YMIX); bf16* CONV = (bf16*)(a.ws + WS_CONV);
    if (cgp < 64) {
        const int c0 = cgp * 8, w = 2 << (c0 >> 7);
        float ps[8];
#pragma unroll
        for (int e = 0; e < 8; ++e) ps[e] = a.in[13][c0 + e];
        for (int blk = blockIdx.x; blk < M / 128; blk += G)
            for (int i = 0; i < 64; ++i) {
                const int m = blk * 128 + i * 2 + rsub, s = m & (SEQ - 1), nv = min(s + 1, w);
                float cur[8], acc[8];
                { const v4u q = *(const v4u*)(PROJ + (size_t)m * NPROJ + c0); unpack8(q, cur); }
#pragma unroll
                for (int e = 0; e < 8; ++e) acc[e] = cur[e];
                for (int j = 1; j < nv; ++j) { float t[8]; const v4u q = *(const v4u*)(PROJ + (size_t)(m - j) * NPROJ + c0); unpack8(q, t);
#pragma unroll
                    for (int e = 0; e < 8; ++e) acc[e] += t[e]; }
                const float inv = 1.0f / (float)nv; float o[8];
#pragma unroll
                for (int e = 0; e < 8; ++e) o[e] = (acc[e] * inv - cur[e]) * ps[e];
                *(v4u*)(YMIX + (size_t)m * MIXW + c0) = pack8(o);
            }
    } else {
        const int ch0 = (cgp - 64) * 8;
        float cw[4][8], cb[8];
#pragma unroll
        for (int e = 0; e < 8; ++e) { cb[e] = a.in[7][ch0 + e];
#pragma unroll
            for (int k = 0; k < 4; ++k) cw[k][e] = a.in[6][k * CONVCH + ch0 + e]; }
        for (int blk = blockIdx.x; blk < M / 128; blk += G)
            for (int i = 0; i < 64; ++i) {
                const int m = blk * 128 + i * 2 + rsub, s = m & (SEQ - 1);
                float acc[8];
#pragma unroll
                for (int e = 0; e < 8; ++e) acc[e] = cb[e];
#pragma unroll
                for (int k = 0; k < 4; ++k) { if (s - 3 + k >= 0) { float t[8]; const v4u q = *(const v4u*)(PROJ + (size_t)(m - 3 + k) * NPROJ + 1536 + ch0); unpack8(q, t);
#pragma unroll
                        for (int e = 0; e < 8; ++e) acc[e] += cw[k][e] * t[e]; } }
#pragma unroll
                for (int e = 0; e < 8; ++e) acc[e] = silu_f(acc[e]);
                *(v4u*)(CONV + (size_t)m * CONVCH + ch0) = pack8(acc);
            }
    }
}

__device__ __forceinline__ void ssd_naive_phase(LAS unsigned char* lds, const Args& a, int G) {
    const int tid = threadIdx.x;
    LAS float* xs = (LAS float*)lds;
    LAS float* Bs = (LAS float*)(lds + 16384);
    LAS float* Cs = (LAS float*)(lds + 49152);
    LAS float* yb = (LAS float*)(lds + 81920);
    LAS float* dts = (LAS float*)(lds + 98304);
    LAS float* dAs = (LAS float*)(lds + 98304 + 256);
    const bf16* PROJ = (const bf16*)(a.ws + WS_PROJ); const bf16* CONV = (const bf16*)(a.ws + WS_CONV);
    bf16* YMIX = (bf16*)(a.ws + WS_YMIX); const float* DT = (const float*)(a.ws + WS_DT); float* SSQ = (float*)(a.ws + WS_SSQ);
    const int p = tid >> 3, nq = tid & 7, n0 = nq * 16;
    for (int it = blockIdx.x; it < BATCH * NHEADS; it += G) {
        const int b = it >> 4, hh = it & 15, g = hh >> 3;
        const float av = -__expf(a.in[9][hh]), dsk = a.in[10][hh];
        float h[16];
#pragma unroll
        for (int i = 0; i < 16; ++i) h[i] = 0.f;
        for (int ck = 0; ck < SEQ / 64; ++ck) {
            const size_t m0 = (size_t)b * SEQ + ck * 64;
            { const int t = tid >> 3, part = tid & 7; float f[8]; unpack8(*(const v4u*)(CONV + (m0 + t) * CONVCH + hh * 64 + part * 8), f);
#pragma unroll
              for (int e = 0; e < 8; ++e) xs[t * 64 + part * 8 + e] = f[e]; }
#pragma unroll
            for (int i = 0; i < 2; ++i) { const int piece = tid + i * NTHR, t = piece >> 4, part = piece & 15; float f[8];
                unpack8(*(const v4u*)(CONV + (m0 + t) * CONVCH + 1024 + g * 128 + part * 8), f);
#pragma unroll
                for (int e = 0; e < 8; ++e) Bs[t * 128 + part * 8 + e] = f[e];
                unpack8(*(const v4u*)(CONV + (m0 + t) * CONVCH + 1280 + g * 128 + part * 8), f);
#pragma unroll
                for (int e = 0; e < 8; ++e) Cs[t * 128 + part * 8 + e] = f[e]; }
            if (tid < 64) { const float dtv = DT[(m0 + tid) * 16 + hh]; dts[tid] = dtv; dAs[tid] = __expf(dtv * av); }
            __syncthreads();
            for (int t = 0; t < 64; ++t) {
                const float xr = xs[t * 64 + p], xv = xr * dts[t], dA = dAs[t];
                float yp = 0.f;
#pragma unroll
                for (int q = 0; q < 4; ++q) { const f32x4 b4 = *(const LAS f32x4*)(Bs + t * 128 + n0 + 4 * q), c4 = *(const LAS f32x4*)(Cs + t * 128 + n0 + 4 * q);
#pragma unroll
                    for (int e = 0; e < 4; ++e) { h[4 * q + e] = h[4 * q + e] * dA + xv * b4[e]; yp += h[4 * q + e] * c4[e]; } }
                yp += __shfl_xor(yp, 1); yp += __shfl_xor(yp, 2); yp += __shfl_xor(yp, 4);
                if (nq == 0) yb[t * 64 + p] = yp + dsk * xr;
            }
            __syncthreads();
            { const int t = tid >> 3, part = tid & 7; float z[8], y[8]; unpack8(*(const v4u*)(PROJ + (m0 + t) * NPROJ + 512 + hh * 64 + part * 8), z);
              float sq = 0.f;
#pragma unroll
              for (int e = 0; e < 8; ++e) { y[e] = yb[t * 64 + part * 8 + e] * silu_f(z[e]); sq += y[e] * y[e]; }
              sq += __shfl_xor(sq, 1); sq += __shfl_xor(sq, 2); sq += __shfl_xor(sq, 4);
              if (part == 0) SSQ[(m0 + t) * 16 + hh] = sq;
              *(v4u*)(YMIX + (m0 + t) * MIXW + 512 + hh * 64 + part * 8) = pack8(y); }
            __syncthreads();
        }
    }
}

__device__ __forceinline__ void ssdnorm_phase(const Args& a, int G) {
    const int tid = threadIdx.x, rsub = tid >> 7, c8 = (tid & 127) * 8, g = c8 >> 9;
    bf16* YMIX = (bf16*)(a.ws + WS_YMIX); const float* SSQ = (const float*)(a.ws + WS_SSQ);
    float gsd[8];
#pragma unroll
    for (int e = 0; e < 8; ++e) gsd[e] = a.in[11][c8 + e];
    for (int r4 = blockIdx.x; r4 < M / 4; r4 += G) {
        const size_t m = (size_t)r4 * 4 + rsub;
        const f32x4 s0 = *(const f32x4*)(SSQ + m * 16 + g * 8), s1 = *(const f32x4*)(SSQ + m * 16 + g * 8 + 4);
        const float ss = ((s0.x + s0.y) + (s0.z + s0.w)) + ((s1.x + s1.y) + (s1.z + s1.w));
        const float rinv = 1.0f / sqrtf(ss * (1.0f / 512.0f) + EPS);
        float y[8]; v4u* pp = (v4u*)(YMIX + m * MIXW + 512 + c8); unpack8(*pp, y);
#pragma unroll
        for (int e = 0; e < 8; ++e) y[e] = y[e] * rinv * gsd[e];
        *pp = pack8(y);
    }
}

__device__ __forceinline__ void finalnorm_phase(const Args& a, int G) {
    const int tid = threadIdx.x, lane = tid & 63, wave = tid >> 6;
    const int gw = blockIdx.x * NWAVES + wave, NGW = G * NWAVES;
    f32x4 gf[4];
#pragma unroll
    for (int j = 0; j < 4; ++j) gf[j] = *(const f32x4*)(a.in[18] + 4 * lane + 256 * j);
    for (int m = gw; m < M; m += NGW) {
        f32x4* xr = (f32x4*)(a.out + (size_t)m * D) + lane;
        f32x4 v[4]; float ss = 0.f;
#pragma unroll
        for (int j = 0; j < 4; ++j) { v[j] = xr[64 * j]; ss += (v[j].x * v[j].x + v[j].y * v[j].y) + (v[j].z * v[j].z + v[j].w * v[j].w); }
        ss = wave_sum(ss);
        const float rinv = 1.0f / sqrtf(ss * (1.0f / D) + EPS);
#pragma unroll
        for (int j = 0; j < 4; ++j) xr[64 * j] = v[j] * rinv * gf[j];
    }
}

constexpr int NPHASES = 11;
__global__ void __launch_bounds__(NTHR, 2) fwd_kernel(Args args) {
    extern __shared__ __attribute__((aligned(16))) unsigned char lds_raw[];
    LAS unsigned char* lds = (LAS unsigned char*)lds_raw;
    cg::grid_group grid = cg::this_grid();
    const int G = gridDim.x, lo = args.ph_lo, hi = args.ph_hi;
    unsigned char* ws = args.ws;
    float* MOD = (float*)(ws + WS_MOD);
#ifndef PH_MASK
#define PH_MASK 0x7ff
#endif
#define IN(k) ((((PH_MASK) >> (k)) & 1) && lo <= (k) && (k) < hi)
#define SEAM(k) do { if (IN(k) && IN((k) + 1)) grid.sync(); } while (0)
    if (IN(0)) { p0_prologue(lds, args, G); } SEAM(0);
    if (IN(1)) { normmod_phase<true>(lds, args.in[0], args.in[4], MOD, 0, 1024, (bf16*)(ws + WS_XN), args.in[5], args.in[8], (float*)(ws + WS_DT), G); __syncthreads(); } SEAM(1);
    if (IN(2)) { pg8::Gemm g{(const bf16*)(ws + WS_XN), (const bf16*)(ws + WS_WIN), M, NPROJ, D}; pg8::StaticOrder S; S.init(M, NPROJ, G, (int)blockIdx.x);
        pg8::EpiBf16<0> E{(bf16*)(ws + WS_PROJ), NPROJ}; pg8::gemm_phase<pg8::EpiBf16<0>, pg8::StaticOrder, true, true>(lds, g, S, E); } SEAM(2);
    if (IN(3)) { halo_phase(args, G); } SEAM(3);
    if (IN(4)) { ssd_naive_phase(lds, args, G); } SEAM(4);
    if (IN(5)) { ssdnorm_phase(args, G); } SEAM(5);
    if (IN(6)) { pg8::Gemm g{(const bf16*)(ws + WS_YMIX), (const bf16*)(ws + WS_WOUT), M, D, MIXW}; pg8::StaticOrder S; S.init(M, D, G, (int)blockIdx.x);
        pg8::EpiResGate E{args.in[0], args.out, MOD + 2048, SEQ, NMOD}; pg8::gemm_phase<pg8::EpiResGate, pg8::StaticOrder, true, true>(lds, g, S, E); } SEAM(6);
    if (IN(7)) { normmod_phase<false>(lds, args.out, args.in[15], MOD, 3072, 4096, (bf16*)(ws + WS_XN), nullptr, nullptr, nullptr, G); } SEAM(7);
    if (IN(8)) { pg8::Gemm g{(const bf16*)(ws + WS_XN), (const bf16*)(ws + WS_WUP), M, FF, D}; pg8::StaticOrder S; S.init(M, FF, G, (int)blockIdx.x);
        pg8::EpiBf16<2> E{(bf16*)(ws + WS_F), FF}; pg8::gemm_phase<pg8::EpiBf16<2>, pg8::StaticOrder, true, true>(lds, g, S, E); } SEAM(8);
    if (IN(9)) { pg8::Gemm g{(const bf16*)(ws + WS_F), (const bf16*)(ws + WS_WDN), M, D, FF}; pg8::StaticOrder S; S.init(M, D, G, (int)blockIdx.x);
        pg8::EpiResGate E{args.out, args.out, MOD + 5120, SEQ, NMOD}; pg8::gemm_phase<pg8::EpiResGate, pg8::StaticOrder, true, true>(lds, g, S, E); } SEAM(9);
    if (IN(10)) { finalnorm_phase(args, G); }
#undef IN
#undef SEAM
}

#ifndef MK_ONE_LAUNCH
#define MK_ONE_LAUNCH 1
#endif
extern "C" void kernel_launch(void* const* d_in, const int* in_sizes, int n_in, void* d_out, int out_size, void* d_ws, size_t ws_size, hipStream_t stream) {
    static int grid = 0;
    if (grid == 0) {
        if (n_in != 19 || out_size != M * D || ws_size < WS_END) { fprintf(stderr, "kernel_launch: unexpected shapes (n_in %d, out %d, ws %zu)\n", n_in, out_size, ws_size); grid = -1; return; }
        int dev = 0, cus = 0, per_cu = 0;
        if (hipGetDevice(&dev) != hipSuccess || hipDeviceGetAttribute(&cus, hipDeviceAttributeMultiprocessorCount, dev) != hipSuccess) { grid = -1; return; }
        if (hipFuncSetAttribute((const void*)fwd_kernel, hipFuncAttributeMaxDynamicSharedMemorySize, LDS_BYTES) != hipSuccess) { fprintf(stderr, "kernel_launch: hipFuncSetAttribute failed\n"); grid = -1; return; }
        if (hipOccupancyMaxActiveBlocksPerMultiprocessor(&per_cu, (const void*)fwd_kernel, NTHR, LDS_BYTES) != hipSuccess || per_cu < 1) { fprintf(stderr, "kernel_launch: occupancy query says %d\n", per_cu); (void)hipGetLastError(); per_cu = 1; }
        grid = cus * per_cu;
        fprintf(stderr, "kernel_launch: grid %d (cus %d x %d)\n", grid, cus, per_cu);
    }
    if (grid < 0) return;
    Args a{};
    for (int i = 0; i < 19; ++i) a.in[i] = (const float*)d_in[i];
    a.out = (float*)d_out; a.ws = (unsigned char*)d_ws;
#if MK_ONE_LAUNCH
    a.ph_lo = 0; a.ph_hi = NPHASES;
    void* kargs[] = {&a};
    hipError_t e = hipLaunchCooperativeKernel((const void*)fwd_kernel, dim3(grid), dim3(NTHR), kargs, LDS_BYTES, stream);
    if (e != hipSuccess) fprintf(stderr, "kernel_launch: cooperative launch failed: %s (grid %d)\n", hipGetErrorString(e), grid);
#else
    for (int ph = 0; ph < NPHASES; ++ph) {
        a.ph_lo = ph; a.ph_hi = ph + 1;
        hipLaunchKernelGGL(fwd_kernel, dim3(grid), dim3(NTHR), LDS_BYTES, stream, a);
    }
#endif
}
```

```cpp
#include <hip/hip_runtime.h>
#include <hip/hip_cooperative_groups.h>
#include <cstdio>
#include <cstdint>
namespace cg = cooperative_groups;
namespace pg8 {
#define PG8_LAS __attribute__((address_space(3)))
typedef unsigned short bf16_t;
typedef short bf16x8 __attribute__((ext_vector_type(8)));
typedef float f32x4 __attribute__((ext_vector_type(4)));
typedef unsigned u32x4 __attribute__((ext_vector_type(4)));
constexpr int BM = 256, BK = 64, HALF = 128, HTB = HALF * BK * 2  , STAGE_BYTES = 8 * HTB, NXCD = 8, WGM = 8;

__host__ __device__ __forceinline__ int lds_byte(int r, int c) { const int st = (r >> 4) * 2 + (c >> 5), rr = r & 15, cc = c & 31, ob = rr * 64 + cc * 2; return st * 1024 + (ob ^ (((ob >> 9) & 1) << 5)); }
__host__ __device__ __forceinline__ void stage_rc(int b, int& R, int& C) { const int st = b / 1024, sb = b % 1024, swz = sb ^ (((sb >> 9) & 1) << 5); R = (st >> 1) * 16 + swz / 64; C = (st & 1) * 32 + (swz % 64) / 2; }
__host__ __device__ __forceinline__ int perm32(int rho) { const int n = rho >> 4, i = rho & 15; return 8 * (i >> 2) + 4 * n + (i & 3); }

struct Unit { int pm, pn; };
struct Gemm { const bf16_t* A; const bf16_t* Bt; int M, N, K; };

struct StaticOrder {
    int nM, nN, nwg, G, c;
    __host__ __device__ void init(int M, int N, int G_, int c_) { nM = M / BM; nN = N / BM; nwg = nM * nN; G = G_; c = c_; }
    __host__ __device__ bool next(int i, Unit& u) const {
        const long L = (long)i * G + c; if (L >= nwg) return false;
        int wgid = (int)L; { const int q = nwg / NXCD, r = nwg % NXCD, xcd = wgid % NXCD, off = wgid / NXCD; wgid = (xcd < r ? xcd * (q + 1) : r * (q + 1) + (xcd - r) * q) + off; }
        const int nig = WGM * nN, gid = wgid / nig, fm = gid * WGM, gsz = (nM - fm) < WGM ? (nM - fm) : WGM;
        u.pm = fm + ((wgid % nig) % gsz); u.pn = (wgid % nig) / gsz; return true;
    }
    __device__ __forceinline__ void a_ready(const Unit&) const {}
    __device__ __forceinline__ void done(const Unit&) const {}
};

__device__ __forceinline__ unsigned cvt_pk_bf16(float lo, float hi) { unsigned r; asm volatile("v_cvt_pk_bf16_f32 %0, %1, %2" : "=v"(r) : "v"(lo), "v"(hi)); return r; }
typedef float f32x2 __attribute__((ext_vector_type(2)));
template <int ACT  > struct EpiBf16 {
    static constexpr bool PERM = true, AFTER_DRAIN = false;
    bf16_t* O; int ldc;
    __device__ __forceinline__ void operator()(const f32x4 (&acc)[2][2][4][2], const Unit& u, int wr, int wc, int fr, int fq) const {
        const int row0 = u.pm * BM + wr * 64 + fr; const int col0 = u.pn * BM + wc * 32 + 8 * fq;
#pragma unroll
        for (int ai = 0; ai < 2; ++ai)
#pragma unroll
            for (int m = 0; m < 4; ++m) { bf16_t* rowp = O + (size_t)(row0 + ai * HALF + m * 16) * ldc + col0;
#pragma unroll
                for (int bj = 0; bj < 2; ++bj) { f32x4 v0 = acc[ai][bj][m][0], v1 = acc[ai][bj][m][1];
                    if (ACT == 2) {
#pragma unroll
                        for (int j = 0; j < 4; ++j) { const float a = fmaxf(v0[j], 0.f), b = fmaxf(v1[j], 0.f); v0[j] = a * a; v1[j] = b * b; } }
                    u32x4 w; w.x = cvt_pk_bf16(v0[0], v0[1]); w.y = cvt_pk_bf16(v0[2], v0[3]); w.z = cvt_pk_bf16(v1[0], v1[1]); w.w = cvt_pk_bf16(v1[2], v1[3]);
                    *(u32x4*)(rowp + bj * HALF) = w; } }
    }
};
struct EpiResGate {
    static constexpr bool PERM = false, AFTER_DRAIN = false;
    const float* base; float* out; const float* gate; int rows_per_batch, gate_stride;
    __device__ __forceinline__ void operator()(const f32x4 (&acc)[2][2][4][2], const Unit& u, int wr, int wc, int fr, int fq) const {
        const int row0 = u.pm * BM + wr * 64 + fr, col0 = u.pn * BM + wc * 32 + 4 * fq;
        const float* gp = gate + (size_t)((u.pm * BM) / rows_per_batch) * gate_stride + col0;
        f32x4 gv[2][2];
#pragma unroll
        for (int bj = 0; bj < 2; ++bj)
#pragma unroll
            for (int n = 0; n < 2; ++n) gv[bj][n] = *(const f32x4*)(gp + bj * HALF + n * 16);
#pragma unroll
        for (int ai = 0; ai < 2; ++ai)
#pragma unroll
            for (int m = 0; m < 4; ++m) { const size_t off = (size_t)(row0 + ai * HALF + m * 16) * 1024 + col0;
#pragma unroll
                for (int bj = 0; bj < 2; ++bj)
#pragma unroll
                    for (int n = 0; n < 2; ++n) { const f32x4 bs = *(const f32x4*)(base + off + bj * HALF + n * 16); *(f32x4*)(out + off + bj * HALF + n * 16) = bs + gv[bj][n] * acc[ai][bj][m][n]; }
                asm volatile("" ::: "memory"); }
    }
};
template <class Epi, class Sched, bool ALIGN_EPI = false, bool SP2 = false>
__device__ __forceinline__ void gemm_phase(PG8_LAS unsigned char* lds, const Gemm g, const Sched& S, const Epi& E) {
    const int tid = threadIdx.x, wid = __builtin_amdgcn_readfirstlane(tid >> 6), lane = tid & 63, wr = wid >> 2, wc = wid & 3, fr = lane & 15, fq = lane >> 4;
    const int K = g.K, nt = K / BK;
    unsigned voffA[2], voffB[2];
#pragma unroll
    for (int i = 0; i < 2; ++i) { int R, C; stage_rc(tid * 16 + i * 8192, R, C); const int Rb = Epi::PERM ? ((R & ~31) + perm32(R & 31)) : R;
        voffA[i] = (unsigned)(R * K + C) * 2u; voffB[i] = (unsigned)(Rb * K + C) * 2u; }
    const size_t kstep = (size_t)(BK * 2);
    const size_t hstep = (size_t)HALF * K * 2;
    const size_t tstep = 2 * hstep;
    const unsigned ldsw = (unsigned)wid * 1024u;
    const int aoff = lds_byte(wr * 64 + fr, fq * 8), boff = lds_byte(wc * 32 + fr, fq * 8);
#define PG8_SA(b, h) (((b) * 2 + (h)) * HTB)
#define PG8_SB(b, h) ((4 + (b) * 2 + (h)) * HTB)
#define PG8_STAGE(bufoff, gbase, voff) do { _Pragma("unroll") for (int _i = 0; _i < 2; ++_i) \
        __builtin_amdgcn_global_load_lds((const unsigned*)((const char*)(gbase) + (voff)[_i]), (PG8_LAS unsigned*)(lds + (bufoff) + ldsw + _i * 8192), 16, 0, 0); } while (0)
#define PG8_LDA(dst, b, h) do { _Pragma("unroll") for (int m = 0; m < 4; ++m) _Pragma("unroll") for (int k = 0; k < 2; ++k) dst[m][k] = *(const PG8_LAS bf16x8*)(lds + PG8_SA(b, h) + aoff + m * 2048 + k * 1024); } while (0)
#define PG8_LDB(dst, b, h) do { _Pragma("unroll") for (int n = 0; n < 2; ++n) _Pragma("unroll") for (int k = 0; k < 2; ++k) dst[n][k] = *(const PG8_LAS bf16x8*)(lds + PG8_SB(b, h) + boff + n * 2048 + k * 1024); } while (0)
#define PG8_MMA(ai, bj, At, Bt) do { __builtin_amdgcn_s_setprio(1); _Pragma("unroll") for (int m = 0; m < 4; ++m) _Pragma("unroll") for (int n = 0; n < 2; ++n) _Pragma("unroll") for (int k = 0; k < 2; ++k) \
        acc[ai][bj][m][n] = __builtin_amdgcn_mfma_f32_16x16x32_bf16(Bt[n][k], At[m][k], acc[ai][bj][m][n], 0, 0, 0); __builtin_amdgcn_s_setprio(0); } while (0)
#define PG8_WAIT_V(n) asm volatile("s_waitcnt vmcnt(" #n ")" ::: "memory")
#define PG8_WAIT_L(n) asm volatile("s_waitcnt lgkmcnt(" #n ")" ::: "memory")
#define PG8_BAR __builtin_amdgcn_s_barrier()
#define PG8_SCHED __builtin_amdgcn_sched_barrier(0)
    Unit cur, nxt; int ui = 0;
    if (!S.next(0, cur)) return;
    f32x4 acc[2][2][4][2];
#pragma unroll
    for (int a = 0; a < 2; ++a)
#pragma unroll
        for (int b = 0; b < 2; ++b)
#pragma unroll
            for (int m = 0; m < 4; ++m)
#pragma unroll
                for (int n = 0; n < 2; ++n) acc[a][b][m][n] = (f32x4){0.f, 0.f, 0.f, 0.f};
    bf16x8 At[4][2], B0[2][2], B1[2][2];
    const char* cA = (const char*)g.A + (size_t)cur.pm * tstep; const char* cB = (const char*)g.Bt + (size_t)cur.pn * tstep;
    S.a_ready(cur);
    if constexpr (SP2) {
        PG8_STAGE(PG8_SB(0, 0), cB, voffB); PG8_STAGE(PG8_SB(0, 1), cB + hstep, voffB); PG8_STAGE(PG8_SA(0, 0), cA, voffA); PG8_STAGE(PG8_SA(0, 1), cA + hstep, voffA);
        if (wr == 1) PG8_BAR;
        PG8_WAIT_V(2); PG8_BAR;
        PG8_STAGE(PG8_SB(1, 0), cB + kstep, voffB); PG8_STAGE(PG8_SA(1, 0), cA + kstep, voffA); PG8_STAGE(PG8_SB(1, 1), cB + hstep + kstep, voffB);
        PG8_WAIT_V(6); PG8_BAR;
    } else {
        PG8_STAGE(PG8_SB(0, 0), cB, voffB); PG8_STAGE(PG8_SA(0, 0), cA, voffA); PG8_STAGE(PG8_SB(0, 1), cB + hstep, voffB); PG8_STAGE(PG8_SA(0, 1), cA + hstep, voffA);
        if (wr == 1) PG8_BAR;
        PG8_WAIT_V(4); PG8_BAR;
        PG8_STAGE(PG8_SB(1, 0), cB + kstep, voffB); PG8_STAGE(PG8_SA(1, 0), cA + kstep, voffA); PG8_STAGE(PG8_SB(1, 1), cB + hstep + kstep, voffB);
        PG8_WAIT_V(6); PG8_BAR;
    }
    for (;;) {
        const bool has_next = S.next(ui + 1, nxt);
        const char* nA = has_next ? (const char*)g.A + (size_t)nxt.pm * tstep : cA; const char* nB = has_next ? (const char*)g.Bt + (size_t)nxt.pn * tstep : cB;
        for (int t = 0; t < nt; t += 2) {
            const bool last = (t == nt - 2);
            const char* a1 = cA + (size_t)(t + 1) * kstep;
            const char* a2 = last ? nA : cA + (size_t)(t + 2) * kstep; const char* b2 = last ? nB : cB + (size_t)(t + 2) * kstep;
            const char* a3 = a2 + kstep; const char* b3 = b2 + kstep;
            if (last && has_next) S.a_ready(nxt);
            if constexpr (SP2) {
            PG8_LDB(B0, 0, 0); PG8_LDB(B1, 0, 1); PG8_SCHED; PG8_LDA(At, 0, 0); PG8_STAGE(PG8_SA(1, 1), a1 + hstep, voffA);
            PG8_WAIT_V(8); PG8_WAIT_L(0); PG8_BAR; PG8_MMA(0, 0, At, B0); PG8_MMA(0, 1, At, B1); PG8_BAR; PG8_SCHED;
            PG8_LDA(At, 0, 1); PG8_STAGE(PG8_SB(0, 0), b2, voffB); PG8_STAGE(PG8_SB(0, 1), b2 + hstep, voffB); PG8_STAGE(PG8_SA(0, 0), a2, voffA);
            PG8_WAIT_V(8); PG8_WAIT_L(0); PG8_BAR; PG8_MMA(1, 0, At, B0); PG8_MMA(1, 1, At, B1); PG8_BAR; PG8_SCHED;
            PG8_LDB(B0, 1, 0); PG8_LDB(B1, 1, 1); PG8_SCHED; PG8_LDA(At, 1, 0); PG8_STAGE(PG8_SA(0, 1), a2 + hstep, voffA);
            PG8_WAIT_V(8); PG8_WAIT_L(0); PG8_BAR; PG8_MMA(0, 0, At, B0); PG8_MMA(0, 1, At, B1); PG8_BAR; PG8_SCHED;
            PG8_LDA(At, 1, 1); PG8_STAGE(PG8_SB(1, 0), b3, voffB); PG8_STAGE(PG8_SB(1, 1), b3 + hstep, voffB); PG8_STAGE(PG8_SA(1, 0), a3, voffA);
            PG8_WAIT_V(8); PG8_WAIT_L(0); PG8_BAR; PG8_MMA(1, 0, At, B0); PG8_MMA(1, 1, At, B1); PG8_BAR; PG8_SCHED;
            } else {
            PG8_LDB(B0, 0, 0); PG8_SCHED; PG8_LDA(At, 0, 0); PG8_STAGE(PG8_SA(1, 1), a1 + hstep, voffA);
            PG8_WAIT_L(8); PG8_BAR; PG8_WAIT_L(0); PG8_MMA(0, 0, At, B0); PG8_BAR; PG8_SCHED;
            PG8_LDB(B1, 0, 1); PG8_STAGE(PG8_SB(0, 0), b2, voffB);
            PG8_BAR; PG8_WAIT_L(0); PG8_MMA(0, 1, At, B1); PG8_BAR;
            PG8_LDA(At, 0, 1); PG8_STAGE(PG8_SA(0, 0), a2, voffA);
            PG8_BAR; PG8_WAIT_L(0); PG8_MMA(1, 0, At, B0); PG8_BAR; PG8_SCHED;
            PG8_STAGE(PG8_SB(0, 1), b2 + hstep, voffB);
            PG8_WAIT_V(6); PG8_BAR; PG8_MMA(1, 1, At, B1); PG8_BAR;
            PG8_LDB(B0, 1, 0); PG8_SCHED; PG8_LDA(At, 1, 0); PG8_STAGE(PG8_SA(0, 1), a2 + hstep, voffA);
            PG8_WAIT_L(8); PG8_BAR; PG8_WAIT_L(0); PG8_MMA(0, 0, At, B0); PG8_BAR; PG8_SCHED;
            PG8_LDB(B1, 1, 1); PG8_STAGE(PG8_SB(1, 0), b3, voffB);
            PG8_BAR; PG8_WAIT_L(0); PG8_MMA(0, 1, At, B1); PG8_BAR;
            PG8_LDA(At, 1, 1); PG8_STAGE(PG8_SA(1, 0), a3, voffA);
            PG8_BAR; PG8_WAIT_L(0); PG8_MMA(1, 0, At, B0); PG8_BAR; PG8_SCHED;
            PG8_STAGE(PG8_SB(1, 1), b3 + hstep, voffB);
            PG8_WAIT_V(6); PG8_BAR; PG8_MMA(1, 1, At, B1); PG8_BAR;
            }
        }
        if constexpr (ALIGN_EPI) { if (wr == 0) PG8_BAR; }
        if constexpr (!Epi::AFTER_DRAIN) { E(acc, cur, wr, wc, fr, fq); S.done(cur); }
        if (!has_next) break;
#pragma unroll
        for (int a = 0; a < 2; ++a)
#pragma unroll
            for (int b = 0; b < 2; ++b)
#pragma unroll
                for (int m = 0; m < 4; ++m)
#pragma unroll
                    for (int n = 0; n < 2; ++n) acc[a][b][m][n] = (f32x4){0.f, 0.f, 0.f, 0.f};
        cur = nxt; cA = nA; cB = nB; ++ui;
        if constexpr (ALIGN_EPI) { if (wr == 1) PG8_BAR; }
    }
    PG8_WAIT_V(0);
    if constexpr (!ALIGN_EPI) { if (wr == 0) PG8_BAR; }
    PG8_BAR;
    if constexpr (Epi::AFTER_DRAIN) { E.fused(acc, cur, wr, wc, fr, fq, lds, wid, lane); S.done(cur); }
#undef PG8_SA
#undef PG8_SB
#undef PG8_STAGE
#undef PG8_LDA
#undef PG8_LDB
#undef PG8_MMA
#undef PG8_WAIT_V
#undef PG8_WAIT_L
#undef PG8_BAR
#undef PG8_SCHED
}
}
#define LAS __attribute__((address_space(3)))
typedef unsigned short bf16;
typedef unsigned v4u __attribute__((ext_vector_type(4)));
typedef unsigned v2u __attribute__((ext_vector_type(2)));
typedef float f32x4 __attribute__((ext_vector_type(4)));
constexpr int D = 1024, BATCH = 16, SEQ = 2048, M = BATCH * SEQ;
constexpr int NHEADS = 16, HD = 64, NST = 128, CONVCH = 1536, MIXW = 1536, INW = 3088, NPROJ = 3072, FF = 4096, NMOD = 6 * D;
constexpr float EPS = 1e-5f;
constexpr int NWAVES = 8, NTHR = 512;
constexpr int LDS_BYTES = 147456;
constexpr size_t MiB = 1u << 20;
constexpr size_t WS_MOD = 0, WS_DT = 2 * MiB, WS_SSQ = 4 * MiB, WS_WIN = 6 * MiB, WS_WOUT = 12 * MiB, WS_WUP = 16 * MiB, WS_WDN = 24 * MiB;
constexpr size_t WS_XN = 32 * MiB, WS_PROJ = 96 * MiB, WS_CONV = 288 * MiB, WS_YMIX = 384 * MiB, WS_F = 96 * MiB, WS_END = 480 * MiB;

__device__ __forceinline__ unsigned f2bf(float f) { unsigned u = __float_as_uint(f); return (u + 0x7fffu + ((u >> 16) & 1u)) >> 16; }
__device__ __forceinline__ unsigned pk2(float lo, float hi) { return f2bf(lo) | (f2bf(hi) << 16); }
__device__ __forceinline__ float bflo(unsigned w) { return __uint_as_float(w << 16); }
__device__ __forceinline__ float bfhi(unsigned w) { return __uint_as_float(w & 0xffff0000u); }
__device__ __forceinline__ void unpack8(const v4u w, float (&f)[8]) { f[0] = bflo(w.x); f[1] = bfhi(w.x); f[2] = bflo(w.y); f[3] = bfhi(w.y); f[4] = bflo(w.z); f[5] = bfhi(w.z); f[6] = bflo(w.w); f[7] = bfhi(w.w); }
__device__ __forceinline__ v4u pack8(const float (&f)[8]) { v4u w; w.x = pk2(f[0], f[1]); w.y = pk2(f[2], f[3]); w.z = pk2(f[4], f[5]); w.w = pk2(f[6], f[7]); return w; }
__device__ __forceinline__ float wave_sum(float v) {
#pragma unroll
    for (int o = 1; o < 64; o <<= 1) v += __shfl_xor(v, o);
    return v;
}
__device__ __forceinline__ float silu_f(float v) { return v / (1.f + __expf(-v)); }
__device__ __forceinline__ float softplus_f(float v) { return fmaxf(v, 0.f) + log1pf(__expf(-fabsf(v))); }

struct Args { const float* in[19]; float* out; unsigned char* ws; int ph_lo, ph_hi; };

__device__ __forceinline__ void transpose_item(const float* W, int ldw, int col0, int K, bf16* WT, int row_off, LAS float* scr, int kb, int nb, int lane) {
    const int k0 = 64 * kb, n0 = 32 * nb;
#pragma unroll 8
    for (int i = 0; i < 32; ++i) { const int kk = 2 * i + (lane >> 5); scr[kk * 33 + (lane & 31)] = W[(size_t)(k0 + kk) * ldw + col0 + n0 + (lane & 31)]; }
    asm volatile("s_waitcnt lgkmcnt(0)" ::: "memory");
    const int c = lane & 7;
#pragma unroll
    for (int j = 0; j < 4; ++j) { const int n = (lane >> 3) + 8 * j; const LAS float* s = scr + (8 * c) * 33 + n;
        v4u o; o.x = pk2(s[0 * 33], s[1 * 33]); o.y = pk2(s[2 * 33], s[3 * 33]); o.z = pk2(s[4 * 33], s[5 * 33]); o.w = pk2(s[6 * 33], s[7 * 33]);
        *(v4u*)(WT + (size_t)(row_off + n0 + n) * K + k0 + 8 * c) = o; }
    asm volatile("s_waitcnt lgkmcnt(0)" ::: "memory");
}

__device__ __forceinline__ void p0_prologue(LAS unsigned char* lds, const Args& a, int G) {
    const int tid = threadIdx.x, lane = tid & 63, wave = tid >> 6;
    unsigned char* ws = a.ws;
    const float* w_in = a.in[5];
    bf16* WtIn = (bf16*)(ws + WS_WIN);
    {
        LAS float* wp = (LAS float*)lds;
        LAS float* win = (LAS float*)(lds + 65536);
        for (int it = blockIdx.x; it < 256; it += G) {
            const int g = it >> 6, k0 = (it & 63) * 16;
            const float* wpg = a.in[12] + (size_t)g * 16384;
            for (int i = tid; i < 16384; i += NTHR) wp[i] = wpg[i];
            for (int i = tid; i < 2048; i += NTHR) { const int kk = i >> 7, c = i & 127; win[i] = w_in[(size_t)(k0 + kk) * INW + g * 128 + c]; }
            __syncthreads();
            const int kk = tid >> 5, d4 = (tid & 31) * 4;
            f32x4 acc = {0.f, 0.f, 0.f, 0.f};
#pragma unroll 8
            for (int c = 0; c < 128; ++c) { const float av = win[kk * 128 + c]; const f32x4 w4 = *(const LAS f32x4*)(wp + c * 128 + d4); acc += av * w4; }
#pragma unroll
            for (int e = 0; e < 4; ++e) WtIn[(size_t)(g * 128 + d4 + e) * D + k0 + kk] = (bf16)f2bf(acc[e]);
            __syncthreads();
        }
    }
    {
        LAS float* cst = (LAS float*)lds;
        LAS float* part = (LAS float*)(lds + 65536);
        const float* cin = a.in[1]; const float* w_ada = a.in[2]; const float* b_ada = a.in[3];
        float* MOD = (float*)(ws + WS_MOD);
        if ((int)blockIdx.x < 192) {
            for (int i = tid; i < 16384; i += NTHR) { const int b = i >> 10, k = i & 1023; cst[k * 16 + b] = silu_f(cin[i]); }
            __syncthreads();
        }
        for (int it = blockIdx.x; it < 192; it += G) {
            const int col0 = it * 32, kh = lane >> 5, col = lane & 31, kbase = wave * 128 + kh * 64;
            float acc[16];
#pragma unroll
            for (int b = 0; b < 16; ++b) acc[b] = 0.f;
#pragma unroll 8
            for (int i = 0; i < 64; ++i) {
                const int k = kbase + i; const float wv = w_ada[(size_t)k * NMOD + col0 + col];
#pragma unroll
                for (int q = 0; q < 4; ++q) { const f32x4 c4 = *(const LAS f32x4*)(cst + k * 16 + 4 * q); acc[4 * q + 0] += c4.x * wv; acc[4 * q + 1] += c4.y * wv; acc[4 * q + 2] += c4.z * wv; acc[4 * q + 3] += c4.w * wv; }
            }
#pragma unroll
            for (int b = 0; b < 16; ++b) part[((wave * 2 + kh) * 16 + b) * 32 + col] = acc[b];
            __syncthreads();
            { const int b = tid >> 5, cc = tid & 31; float s = b_ada[col0 + cc];
#pragma unroll
              for (int p = 0; p < 16; ++p) s += part[(p * 16 + b) * 32 + cc];
              MOD[(size_t)b * NMOD + col0 + cc] = s; }
            __syncthreads();
        }
    }
    __syncthreads();
    {
        LAS float* scr = (LAS float*)(lds + wave * 16384);
        const int gw = blockIdx.x * NWAVES + wave, NGW = G * NWAVES;
        constexpr int I_IN = 16 * 80, I_OUT = 24 * 32, I_UP = 16 * 128, I_DN = 64 * 32;
        for (int it = gw; it < I_IN + I_OUT + I_UP + I_DN; it += NGW) {
            int r = it;
            if (r < I_IN) { transpose_item(w_in, INW, 512, D, WtIn, 512, scr, r / 80, r % 80, lane); continue; } r -= I_IN;
            if (r < I_OUT) { transpose_item(a.in[14], D, 0, MIXW, (bf16*)(ws + WS_WOUT), 0, scr, r / 32, r % 32, lane); continue; } r -= I_OUT;
            if (r < I_UP) { transpose_item(a.in[16], FF, 0, D, (bf16*)(ws + WS_WUP), 0, scr, r / 128, r % 128, lane); continue; } r -= I_UP;
            transpose_item(a.in[17], D, 0, FF, (bf16*)(ws + WS_WDN), 0, scr, r / 32, r % 32, lane);
        }
    }
}

template <bool WITH_DT>
__device__ __forceinline__ void normmod_phase(LAS unsigned char* lds, const float* src, const float* gvec, const float* MOD, int shift_ofs, int scale_ofs, bf16* XN,
                                              const float* w_in, const float* dt_bias, float* DT, int G) {
    const int tid = threadIdx.x, lane = tid & 63, wave = tid >> 6;
    LAS float* WdtL = (LAS float*)lds;
    if (WITH_DT) {
        for (int i = tid; i < 16384; i += NTHR) { const int k = i >> 4, h = i & 15; WdtL[h * 1024 + k] = w_in[(size_t)k * INW + NPROJ + h]; }
        __syncthreads();
    }
    const int gw = blockIdx.x * NWAVES + wave, NGW = G * NWAVES;
    for (int rg = gw; rg < M / 16; rg += NGW) {
        const int m0 = rg * 16, b = m0 / SEQ;
        const float* mp = MOD + (size_t)b * NMOD;
        f32x4 gs[4], sh[4];
#pragma unroll
        for (int j = 0; j < 4; ++j) { const int k = 4 * lane + 256 * j; const f32x4 g4 = *(const f32x4*)(gvec + k); const f32x4 sc = *(const f32x4*)(mp + scale_ofs + k); gs[j] = g4 * (sc + 1.0f); sh[j] = *(const f32x4*)(mp + shift_ofs + k); }
        for (int r = 0; r < 16; ++r) {
            const int m = m0 + r;
            const f32x4* xr = (const f32x4*)(src + (size_t)m * D) + lane;
            f32x4 v[4]; float ss = 0.f;
#pragma unroll
            for (int j = 0; j < 4; ++j) { v[j] = xr[64 * j]; ss += (v[j].x * v[j].x + v[j].y * v[j].y) + (v[j].z * v[j].z + v[j].w * v[j].w); }
            ss = wave_sum(ss);
            const float rinv = 1.0f / sqrtf(ss * (1.0f / D) + EPS);
#pragma unroll
            for (int j = 0; j < 4; ++j) v[j] = v[j] * rinv * gs[j] + sh[j];
            unsigned long long* o8 = (unsigned long long*)(XN + (size_t)m * D) + lane;
#pragma unroll
            for (int j = 0; j < 4; ++j) o8[64 * j] = (unsigned long long)pk2(v[j].x, v[j].y) | ((unsigned long long)pk2(v[j].z, v[j].w) << 32);
            if (WITH_DT) {
                float acc[16];
#pragma unroll
                for (int h = 0; h < 16; ++h) { float s = 0.f;
#pragma unroll
                    for (int j = 0; j < 4; ++j) { const f32x4 w4 = *(const LAS f32x4*)(WdtL + h * 1024 + 4 * lane + 256 * j); s += (v[j].x * w4.x + v[j].y * w4.y) + (v[j].z * w4.z + v[j].w * w4.w); }
                    acc[h] = s; if ((h & 3) == 3) asm volatile("" ::: "memory"); }
                float a8[8], a4[4], a2[2], a1;
                const bool u5 = (lane & 32) != 0, u4 = (lane & 16) != 0, u3 = (lane & 8) != 0, u2 = (lane & 4) != 0;
#pragma unroll
                for (int i = 0; i < 8; ++i) { const float keep = u5 ? acc[i + 8] : acc[i], send = u5 ? acc[i] : acc[i + 8]; a8[i] = keep + __shfl_xor(send, 32); }
#pragma unroll
                for (int i = 0; i < 4; ++i) { const float keep = u4 ? a8[i + 4] : a8[i], send = u4 ? a8[i] : a8[i + 4]; a4[i] = keep + __shfl_xor(send, 16); }
#pragma unroll
                for (int i = 0; i < 2; ++i) { const float keep = u3 ? a4[i + 2] : a4[i], send = u3 ? a4[i] : a4[i + 2]; a2[i] = keep + __shfl_xor(send, 8); }
                { const float keep = u2 ? a2[1] : a2[0], send = u2 ? a2[0] : a2[1]; a1 = keep + __shfl_xor(send, 4); }
                a1 += __shfl_xor(a1, 2); a1 += __shfl_xor(a1, 1);
                const int h = ((lane >> 5) & 1) * 8 + ((lane >> 4) & 1) * 4 + ((lane >> 3) & 1) * 2 + ((lane >> 2) & 1);
                if ((lane & 3) == 0) DT[(size_t)m * 16 + h] = softplus_f(a1 + dt_bias[h]);
            }
        }
    }
}

template <int TAPS, bool POOL>
__device__ __forceinline__ void fir_rows(const Args& a, int G, int cgi, int rsub) {
    const bf16* PROJ = (const bf16*)(a.ws + WS_PROJ);
    const int c0 = cgi * 8;
    const bf16* src = PROJ + (POOL ? 0 : 1536) + c0;
    bf16* dst = POOL ? (bf16*)(a.ws + WS_YMIX) + c0 : (bf16*)(a.ws + WS_CONV) + c0;
    const int dstride = POOL ? MIXW : CONVCH;
    const int w = POOL ? (2 << (c0 >> 7)) : 4;
    float pa[8], pb[4][8];
#pragma unroll
    for (int e = 0; e < 8; ++e) { pa[e] = POOL ? a.in[13][c0 + e] : a.in[7][c0 + e];
#pragma unroll
        for (int k = 0; k < 4; ++k) pb[k][e] = POOL ? 0.f : a.in[6][k * CONVCH + c0 + e]; }
    for (int blk = blockIdx.x; blk < M / 128; blk += G)
        for (int i = 0; i < 16; ++i) {
            const int m0 = blk * 128 + (i * 2 + rsub) * 4, s0 = m0 & (SEQ - 1);
            v4u L[TAPS + 3];
#pragma unroll
            for (int r = 0; r < TAPS + 3; ++r) { const int rel = r - (TAPS - 1);
                if (s0 + rel >= 0) L[r] = *(const v4u*)(src + (size_t)(m0 + rel) * NPROJ); else L[r] = (v4u){0u, 0u, 0u, 0u}; }
#pragma unroll
            for (int o = 0; o < 4; ++o) {
                float acc[8];
                if (POOL) {
                    const int nv = min(s0 + o + 1, w); const float inv = 1.0f / (float)nv;
#pragma unroll
                    for (int e = 0; e < 8; ++e) acc[e] = 0.f;
#pragma unroll
                    for (int j = 0; j < TAPS; ++j) { float t[8]; unpack8(L[TAPS - 1 + o - j], t); const float cj = (j < nv) ? 1.0f : 0.0f;
#pragma unroll
                        for (int e = 0; e < 8; ++e) acc[e] += cj * t[e]; }
                    float cur[8]; unpack8(L[TAPS - 1 + o], cur);
#pragma unroll
                    for (int e = 0; e < 8; ++e) acc[e] = (acc[e] * inv - cur[e]) * pa[e];
                } else {
#pragma unroll
                    for (int e = 0; e < 8; ++e) acc[e] = pa[e];
#pragma unroll
                    for (int k = 0; k < 4; ++k) { float t[8]; unpack8(L[o + k], t);
#pragma unroll
                        for (int e = 0; e < 8; ++e) acc[e] += pb[k][e] * t[e]; }
#pragma unroll
                    for (int e = 0; e < 8; ++e) acc[e] = silu_f(acc[e]);
                }
                *(v4u*)(dst + (size_t)(m0 + o) * dstride) = pack8(acc);
            }
        }
}
__device__ __forceinline__ void halo_phase(const Args& a, int G) {
    const int tid = threadIdx.x, cgp = tid & 255, rsub = tid >> 8;
    if (cgp < 64) fir_rows<16, true>(a, G, cgp, rsub); else fir_rows<4, false>(a, G, cgp - 64, rsub);
}

__device__ __forceinline__ void ssd_naive_phase(LAS unsigned char* lds, const Args& a, int G) {
    const int tid = threadIdx.x;
    LAS float* xs = (LAS float*)lds;
    LAS float* Bs = (LAS float*)(lds + 16384);
    LAS float* Cs = (LAS float*)(lds + 49152);
    LAS float* yb = (LAS float*)(lds + 81920);
    LAS float* dts = (LAS float*)(lds + 98304);
    LAS float* dAs = (LAS float*)(lds + 98304 + 256);
    const bf16* PROJ = (const bf16*)(a.ws + WS_PROJ); const bf16* CONV = (const bf16*)(a.ws + WS_CONV);
    bf16* YMIX = (bf16*)(a.ws + WS_YMIX); const float* DT = (const float*)(a.ws + WS_DT); float* SSQ = (float*)(a.ws + WS_SSQ);
    const int p = tid >> 3, nq = tid & 7, n0 = nq * 16;
    for (int it = blockIdx.x; it < BATCH * NHEADS; it += G) {
        const int b = it >> 4, hh = it & 15, g = hh >> 3;
        const float av = -__expf(a.in[9][hh]), dsk = a.in[10][hh];
        float h[16];
#pragma unroll
        for (int i = 0; i < 16; ++i) h[i] = 0.f;
        for (int ck = 0; ck < SEQ / 64; ++ck) {
            const size_t m0 = (size_t)b * SEQ + ck * 64;
            { const int t = tid >> 3, part = tid & 7; float f[8]; unpack8(*(const v4u*)(CONV + (m0 + t) * CONVCH + hh * 64 + part * 8), f);
#pragma unroll
              for (int e = 0; e < 8; ++e) xs[t * 64 + part * 8 + e] = f[e]; }
#pragma unroll
            for (int i = 0; i < 2; ++i) { const int piece = tid + i * NTHR, t = piece >> 4, part = piece & 15; float f[8];
                unpack8(*(const v4u*)(CONV + (m0 + t) * CONVCH + 1024 + g * 128 + part * 8), f);
#pragma unroll
                for (int e = 0; e < 8; ++e) Bs[t * 128 + part * 8 + e] = f[e];
                unpack8(*(const v4u*)(CONV + (m0 + t) * CONVCH + 1280 + g * 128 + part * 8), f);
#pragma unroll
                for (int e = 0; e < 8; ++e) Cs[t * 128 + part * 8 + e] = f[e]; }
            if (tid < 64) { const float dtv = DT[(m0 + tid) * 16 + hh]; dts[tid] = dtv; dAs[tid] = __expf(dtv * av); }
            __syncthreads();
            for (int t = 0; t < 64; ++t) {
                const float xr = xs[t * 64 + p], xv = xr * dts[t], dA = dAs[t];
                float yp = 0.f;
#pragma unroll
                for (int q = 0; q < 4; ++q) { const f32x4 b4 = *(const LAS f32x4*)(Bs + t * 128 + n0 + 4 * q), c4 = *(const LAS f32x4*)(Cs + t * 128 + n0 + 4 * q);
#pragma unroll
                    for (int e = 0; e < 4; ++e) { h[4 * q + e] = h[4 * q + e] * dA + xv * b4[e]; yp += h[4 * q + e] * c4[e]; } }
                yp += __shfl_xor(yp, 1); yp += __shfl_xor(yp, 2); yp += __shfl_xor(yp, 4);
                if (nq == 0) yb[t * 64 + p] = yp + dsk * xr;
            }
            __syncthreads();
            { const int t = tid >> 3, part = tid & 7; float z[8], y[8]; unpack8(*(const v4u*)(PROJ + (m0 + t) * NPROJ + 512 + hh * 64 + part * 8), z);
              float sq = 0.f;
#pragma unroll
              for (int e = 0; e < 8; ++e) { y[e] = yb[t * 64 + part * 8 + e] * silu_f(z[e]); sq += y[e] * y[e]; }
              sq += __shfl_xor(sq, 1); sq += __shfl_xor(sq, 2); sq += __shfl_xor(sq, 4);
              if (part == 0) SSQ[(m0 + t) * 16 + hh] = sq;
              *(v4u*)(YMIX + (m0 + t) * MIXW + 512 + hh * 64 + part * 8) = pack8(y); }
            __syncthreads();
        }
    }
}

typedef short s16x4 __attribute__((ext_vector_type(4)));
typedef short bf16x8 __attribute__((ext_vector_type(8)));
__device__ __forceinline__ bf16x8 frag_row(LAS unsigned char* base, int stride, int row0, int k0, int x, int y) { return *(const LAS bf16x8*)(base + (row0 + x) * stride + (k0 + 8 * y) * 2); }
__device__ __forceinline__ bf16x8 frag_tr(LAS unsigned char* base, int stride, int krow0, int col0, int lane) {
    const int y = lane >> 4, q = (lane >> 2) & 3, p = lane & 3;
    LAS unsigned char* a0 = base + (krow0 + 4 * y + q) * stride + (col0 + 4 * p) * 2;
    const s16x4 r0 = __builtin_amdgcn_ds_read_tr16_b64_v4i16((LAS s16x4*)a0);
    const s16x4 r1 = __builtin_amdgcn_ds_read_tr16_b64_v4i16((LAS s16x4*)(a0 + 16 * stride));
    return __builtin_shufflevector(r0, r1, 0, 1, 2, 3, 4, 5, 6, 7);
}
__device__ __forceinline__ void ssd_chunk_phase(LAS unsigned char* lds, const Args& a, int G) {
    const int tid = threadIdx.x, lane = tid & 63, w = __builtin_amdgcn_readfirstlane(tid >> 6), x = lane & 15, y = lane >> 4;
    constexpr int CS = 0, CSS = 272, BS = 34816, BSS = 288, XS = 71680, XSS = 160, XW = 92160, HB = 112640, HBS = 272, TAB = 130048;
    LAS float* t_acum = (LAS float*)(lds + TAB); LAS float* t_dt = t_acum + 128; LAS float* t_ea = t_acum + 256; LAS float* t_wl = t_acum + 384; LAS float* t_misc = t_acum + 512;
    const bf16* PROJ = (const bf16*)(a.ws + WS_PROJ); const bf16* CONV = (const bf16*)(a.ws + WS_CONV);
    bf16* YMIX = (bf16*)(a.ws + WS_YMIX); const float* DT = (const float*)(a.ws + WS_DT); float* SSQ = (float*)(a.ws + WS_SSQ);
    for (int it0 = blockIdx.x; it0 < BATCH * NHEADS; it0 += G) {
        const int xcd = it0 & 7, slot = it0 >> 3, qq = xcd * 4 + (slot >> 3), b = qq >> 1, g = qq & 1, hh = g * 8 + (slot & 7);
        const float av = -__expf(a.in[9][hh]), dsk = a.in[10][hh];
        f32x4 hst[4];
#pragma unroll
        for (int nt = 0; nt < 4; ++nt) hst[nt] = (f32x4){0.f, 0.f, 0.f, 0.f};
        v4u rc[4], rb[4], rx[2]; float d0 = 0.f, d1 = 0.f;
        const bf16* cbase = CONV + (size_t)b * SEQ * CONVCH;
#define SSD_LOAD(ck_) do { const bf16* cb_ = cbase + (size_t)(ck_) * 128 * CONVCH; \
            _Pragma("unroll") for (int i = 0; i < 4; ++i) { const int piece = tid + i * NTHR, row = piece >> 4, part = piece & 15; \
                rc[i] = *(const v4u*)(cb_ + (size_t)row * CONVCH + 1280 + g * 128 + part * 8); rb[i] = *(const v4u*)(cb_ + (size_t)row * CONVCH + 1024 + g * 128 + part * 8); } \
            _Pragma("unroll") for (int i = 0; i < 2; ++i) { const int piece = tid + i * NTHR, row = piece >> 3, part = piece & 7; rx[i] = *(const v4u*)(cb_ + (size_t)row * CONVCH + hh * 64 + part * 8); } \
            if (w == 0) { const size_t mm_ = (size_t)b * SEQ + (ck_) * 128 + 2 * lane; d0 = DT[mm_ * 16 + hh]; d1 = DT[(mm_ + 1) * 16 + hh]; } } while (0)
        SSD_LOAD(0);
        for (int ck = 0; ck < SEQ / 128; ++ck) {
            const size_t m0 = (size_t)b * SEQ + ck * 128;
            const int l = 16 * w + x;
            v2u rz[4];
#pragma unroll
            for (int pt = 0; pt < 4; ++pt) rz[pt] = *(const v2u*)(PROJ + (m0 + l) * NPROJ + 512 + hh * 64 + 16 * pt + 4 * y);
            if (w == 0) {
                const float a0 = d0 * av, a1 = d1 * av; float sc = a0 + a1;
#pragma unroll
                for (int o = 1; o < 64; o <<= 1) { const float t = __shfl_up(sc, o); if (lane >= o) sc += t; }
                const float c1 = sc, c0 = sc - a1, alast = __shfl(sc, 63);
                t_acum[2 * lane] = c0; t_acum[2 * lane + 1] = c1; t_dt[2 * lane] = d0; t_dt[2 * lane + 1] = d1;
                t_ea[2 * lane] = __expf(c0); t_ea[2 * lane + 1] = __expf(c1);
                t_wl[2 * lane] = d0 * __expf(alast - c0); t_wl[2 * lane + 1] = d1 * __expf(alast - c1);
                if (lane == 0) t_misc[0] = __expf(alast);
            }
#pragma unroll
            for (int i = 0; i < 4; ++i) { const int piece = tid + i * NTHR, row = piece >> 4, part = piece & 15;
                *(LAS v4u*)(lds + CS + row * CSS + part * 16) = rc[i]; *(LAS v4u*)(lds + BS + row * BSS + part * 16) = rb[i]; }
#pragma unroll
            for (int i = 0; i < 2; ++i) { const int piece = tid + i * NTHR, row = piece >> 3, part = piece & 7; *(LAS v4u*)(lds + XS + row * XSS + part * 16) = rx[i]; }
#pragma unroll
            for (int nt = 0; nt < 4; ++nt) { const int p = 16 * (w & 3) + x, n = 16 * (4 * (w >> 2) + nt) + 4 * y;
                *(LAS v2u*)(lds + HB + p * HBS + n * 2) = (v2u){pk2(hst[nt].x, hst[nt].y), pk2(hst[nt].z, hst[nt].w)}; }
            __syncthreads();
#pragma unroll
            for (int i = 0; i < 2; ++i) { const int piece = tid + i * NTHR, row = piece >> 3, part = piece & 7; const float wl = t_wl[row]; float f[8]; unpack8(rx[i], f);
#pragma unroll
                for (int e = 0; e < 8; ++e) f[e] *= wl;
                *(LAS v4u*)(lds + XW + row * XSS + part * 16) = pack8(f); }
            __syncthreads();
            if (ck + 1 < SEQ / 128) SSD_LOAD(ck + 1);
            bf16x8 cf[4];
#pragma unroll
            for (int ks = 0; ks < 4; ++ks) cf[ks] = frag_row(lds + CS, CSS, 16 * w, 32 * ks, x, y);
            f32x4 sacc[8];
#pragma unroll
            for (int ts = 0; ts < 8; ++ts) { sacc[ts] = (f32x4){0.f, 0.f, 0.f, 0.f};
#pragma unroll
                for (int ks = 0; ks < 4; ++ks) sacc[ts] = __builtin_amdgcn_mfma_f32_16x16x32_bf16(frag_row(lds + BS, BSS, 16 * ts, 32 * ks, x, y), cf[ks], sacc[ts], 0, 0, 0); }
            f32x4 yacc[4];
            const float ea_l = t_ea[l], ac_l = t_acum[l];
#pragma unroll
            for (int pt = 0; pt < 4; ++pt) { yacc[pt] = (f32x4){0.f, 0.f, 0.f, 0.f};
#pragma unroll
                for (int ks = 0; ks < 4; ++ks) yacc[pt] = __builtin_amdgcn_mfma_f32_16x16x32_bf16(frag_row(lds + HB, HBS, 16 * pt, 32 * ks, x, y), cf[ks], yacc[pt], 0, 0, 0);
                yacc[pt] = yacc[pt] * ea_l; }
#pragma unroll
            for (int ts = 0; ts < 8; ++ts) { const f32x4 as = *(const LAS f32x4*)(t_acum + 16 * ts + 4 * y), ds = *(const LAS f32x4*)(t_dt + 16 * ts + 4 * y); float gv[4];
#pragma unroll
                for (int e = 0; e < 4; ++e) { const int s = 16 * ts + 4 * y + e; const float ev = (s <= l) ? __expf(ac_l - as[e]) : 0.f; gv[e] = sacc[ts][e] * ev * ds[e]; }
                const int c = 32 * (ts >> 1) + 8 * y + 4 * (ts & 1);
                *(LAS v2u*)(lds + CS + l * CSS + c * 2) = (v2u){pk2(gv[0], gv[1]), pk2(gv[2], gv[3])}; }
            { const float cd = t_misc[0];
#pragma unroll
              for (int nt = 0; nt < 4; ++nt) hst[nt] = hst[nt] * cd;
#pragma unroll
              for (int ks = 0; ks < 4; ++ks) { const bf16x8 xf = frag_tr(lds + XW, XSS, 32 * ks, 16 * (w & 3), lane);
#pragma unroll
                  for (int nt = 0; nt < 4; ++nt) hst[nt] = __builtin_amdgcn_mfma_f32_16x16x32_bf16(frag_tr(lds + BS, BSS, 32 * ks, 16 * (4 * (w >> 2) + nt), lane), xf, hst[nt], 0, 0, 0); } }
#pragma unroll
            for (int ks = 0; ks < 4; ++ks) { const bf16x8 gf = frag_row(lds + CS, CSS, 16 * w, 32 * ks, x, y);
#pragma unroll
                for (int pt = 0; pt < 4; ++pt) yacc[pt] = __builtin_amdgcn_mfma_f32_16x16x32_bf16(frag_tr(lds + XS, XSS, 32 * ks, 16 * pt, lane), gf, yacc[pt], 0, 0, 0); }
            { const size_t m = m0 + l; float sq = 0.f;
#pragma unroll
              for (int pt = 0; pt < 4; ++pt) { const v2u xr = *(const LAS v2u*)(lds + XS + l * XSS + (16 * pt + 4 * y) * 2);
                  const float y0 = (yacc[pt].x + dsk * bflo(xr.x)) * silu_f(bflo(rz[pt].x)), y1 = (yacc[pt].y + dsk * bfhi(xr.x)) * silu_f(bfhi(rz[pt].x));
                  const float y2 = (yacc[pt].z + dsk * bflo(xr.y)) * silu_f(bflo(rz[pt].y)), y3 = (yacc[pt].w + dsk * bfhi(xr.y)) * silu_f(bfhi(rz[pt].y));
                  sq += (y0 * y0 + y1 * y1) + (y2 * y2 + y3 * y3);
                  *(v2u*)(YMIX + m * MIXW + 512 + hh * 64 + 16 * pt + 4 * y) = (v2u){pk2(y0, y1), pk2(y2, y3)}; }
              sq += __shfl_xor(sq, 16); sq += __shfl_xor(sq, 32);
              if (y == 0) SSQ[m * 16 + hh] = sq; }
            __syncthreads();
        }
#undef SSD_LOAD
    }
}

__device__ __forceinline__ void ssdnorm_phase(const Args& a, int G) {
    const int tid = threadIdx.x, rsub = tid >> 7, c8 = (tid & 127) * 8, g = c8 >> 9;
    bf16* YMIX = (bf16*)(a.ws + WS_YMIX); const float* SSQ = (const float*)(a.ws + WS_SSQ);
    float gsd[8];
#pragma unroll
    for (int e = 0; e < 8; ++e) gsd[e] = a.in[11][c8 + e];
    for (int r4 = blockIdx.x; r4 < M / 4; r4 += G) {
        const size_t m = (size_t)r4 * 4 + rsub;
        const f32x4 s0 = *(const f32x4*)(SSQ + m * 16 + g * 8), s1 = *(const f32x4*)(SSQ + m * 16 + g * 8 + 4);
        const float ss = ((s0.x + s0.y) + (s0.z + s0.w)) + ((s1.x + s1.y) + (s1.z + s1.w));
        const float rinv = 1.0f / sqrtf(ss * (1.0f / 512.0f) + EPS);
        float y[8]; v4u* pp = (v4u*)(YMIX + m * MIXW + 512 + c8); unpack8(*pp, y);
#pragma unroll
        for (int e = 0; e < 8; ++e) y[e] = y[e] * rinv * gsd[e];
        *pp = pack8(y);
    }
}

__device__ __forceinline__ void finalnorm_phase(const Args& a, int G) {
    const int tid = threadIdx.x, lane = tid & 63, wave = tid >> 6;
    const int gw = blockIdx.x * NWAVES + wave, NGW = G * NWAVES;
    f32x4 gf[4];
#pragma unroll
    for (int j = 0; j < 4; ++j) gf[j] = *(const f32x4*)(a.in[18] + 4 * lane + 256 * j);
    for (int m = gw; m < M; m += NGW) {
        f32x4* xr = (f32x4*)(a.out + (size_t)m * D) + lane;
        f32x4 v[4]; float ss = 0.f;
#pragma unroll
        for (int j = 0; j < 4; ++j) { v[j] = xr[64 * j]; ss += (v[j].x * v[j].x + v[j].y * v[j].y) + (v[j].z * v[j].z + v[j].w * v[j].w); }
        ss = wave_sum(ss);
        const float rinv = 1.0f / sqrtf(ss * (1.0f / D) + EPS);
#pragma unroll
        for (int j = 0; j < 4; ++j) xr[64 * j] = v[j] * rinv * gf[j];
    }
}

constexpr int NPHASES = 11;
__global__ void __launch_bounds__(NTHR, 2) fwd_kernel(Args args) {
    extern __shared__ __attribute__((aligned(16))) unsigned char lds_raw[];
    LAS unsigned char* lds = (LAS unsigned char*)lds_raw;
    cg::grid_group grid = cg::this_grid();
    const int G = gridDim.x, lo = args.ph_lo, hi = args.ph_hi;
    unsigned char* ws = args.ws;
    float* MOD = (float*)(ws + WS_MOD);
#ifndef PH_MASK
#define PH_MASK 0x7ff
#endif
#define IN(k) ((((PH_MASK) >> (k)) & 1) && lo <= (k) && (k) < hi)
#define SEAM(k) do { if (IN(k) && IN((k) + 1)) grid.sync(); } while (0)
    if (IN(0)) { p0_prologue(lds, args, G); } SEAM(0);
    if (IN(1)) { normmod_phase<true>(lds, args.in[0], args.in[4], MOD, 0, 1024, (bf16*)(ws + WS_XN), args.in[5], args.in[8], (float*)(ws + WS_DT), G); __syncthreads(); } SEAM(1);
    if (IN(2)) { pg8::Gemm g{(const bf16*)(ws + WS_XN), (const bf16*)(ws + WS_WIN), M, NPROJ, D}; pg8::StaticOrder S; S.init(M, NPROJ, G, (int)blockIdx.x);
        pg8::EpiBf16<0> E{(bf16*)(ws + WS_PROJ), NPROJ}; pg8::gemm_phase<pg8::EpiBf16<0>, pg8::StaticOrder, true, true>(lds, g, S, E); } SEAM(2);
    if (IN(3)) { halo_phase(args, G); } SEAM(3);
    #ifdef SSD_NAIVE
    if (IN(4)) { ssd_naive_phase(lds, args, G); } SEAM(4);
#else
    if (IN(4)) { ssd_chunk_phase(lds, args, G); } SEAM(4);
#endif
    if (IN(5)) { ssdnorm_phase(args, G); } SEAM(5);
    if (IN(6)) { pg8::Gemm g{(const bf16*)(ws + WS_YMIX), (const bf16*)(ws + WS_WOUT), M, D, MIXW}; pg8::StaticOrder S; S.init(M, D, G, (int)blockIdx.x);
        pg8::EpiResGate E{args.in[0], args.out, MOD + 2048, SEQ, NMOD}; pg8::gemm_phase<pg8::EpiResGate, pg8::StaticOrder, true, true>(lds, g, S, E); } SEAM(6);
    if (IN(7)) { normmod_phase<false>(lds, args.out, args.in[15], MOD, 3072, 4096, (bf16*)(ws + WS_XN), nullptr, nullptr, nullptr, G); } SEAM(7);
    if (IN(8)) { pg8::Gemm g{(const bf16*)(ws + WS_XN), (const bf16*)(ws + WS_WUP), M, FF, D}; pg8::StaticOrder S; S.init(M, FF, G, (int)blockIdx.x);
        pg8::EpiBf16<2> E{(bf16*)(ws + WS_F), FF}; pg8::gemm_phase<pg8::EpiBf16<2>, pg8::StaticOrder, true, true>(lds, g, S, E); } SEAM(8);
    if (IN(9)) { pg8::Gemm g{(const bf16*)(ws + WS_F), (const bf16*)(ws + WS_WDN), M, D, FF}; pg8::StaticOrder S; S.init(M, D, G, (int)blockIdx.x);
        pg8::EpiResGate E{args.out, args.out, MOD + 5120, SEQ, NMOD}; pg8::gemm_phase<pg8::EpiResGate, pg8::StaticOrder, true, true>(lds, g, S, E); } SEAM(9);
    if (IN(10)) { finalnorm_phase(args, G); }
#undef IN
#undef SEAM
}

#ifndef MK_ONE_LAUNCH
#define MK_ONE_LAUNCH 1
#endif
extern "C" void kernel_launch(void* const* d_in, const int* in_sizes, int n_in, void* d_out, int out_size, void* d_ws, size_t ws_size, hipStream_t stream) {
    static int grid = 0;
    if (grid == 0) {
        if (n_in != 19 || out_size != M * D || ws_size < WS_END) { fprintf(stderr, "kernel_launch: unexpected shapes (n_in %d, out %d, ws %zu)\n", n_in, out_size, ws_size); grid = -1; return; }
        int dev = 0, cus = 0, per_cu = 0;
        if (hipGetDevice(&dev) != hipSuccess || hipDeviceGetAttribute(&cus, hipDeviceAttributeMultiprocessorCount, dev) != hipSuccess) { grid = -1; return; }
        if (hipFuncSetAttribute((const void*)fwd_kernel, hipFuncAttributeMaxDynamicSharedMemorySize, LDS_BYTES) != hipSuccess) { fprintf(stderr, "kernel_launch: hipFuncSetAttribute failed\n"); grid = -1; return; }
        if (hipOccupancyMaxActiveBlocksPerMultiprocessor(&per_cu, (const void*)fwd_kernel, NTHR, LDS_BYTES) != hipSuccess || per_cu < 1) { fprintf(stderr, "kernel_launch: occupancy query says %d\n", per_cu); (void)hipGetLastError(); per_cu = 1; }
        grid = cus * per_cu;
        fprintf(stderr, "kernel_launch: grid %d (cus %d x %d)\n", grid, cus, per_cu);
    }
    if (grid < 0) return;
    Args a{};
    for (int i = 0; i < 19; ++i) a.in[i] = (const float*)d_in[i];
    a.out = (float*)d_out; a.ws = (unsigned char*)d_ws;
#if MK_ONE_LAUNCH
    a.ph_lo = 0; a.ph_hi = NPHASES;
    void* kargs[] = {&a};
    hipError_t e = hipLaunchCooperativeKernel((const void*)fwd_kernel, dim3(grid), dim3(NTHR), kargs, LDS_BYTES, stream);
    if (e != hipSuccess) fprintf(stderr, "kernel_launch: cooperative launch failed: %s (grid %d)\n", hipGetErrorString(e), grid);
#else
    for (int ph = 0; ph < NPHASES; ++ph) {
        a.ph_lo = ph; a.ph_hi = ph + 1;
        hipLaunchKernelGGL(fwd_kernel, dim3(grid), dim3(NTHR), LDS_BYTES, stream, a);
    }
#endif
}
```

```cpp
#include <hip/hip_runtime.h>
#include <hip/hip_cooperative_groups.h>
#include <cstdio>
#include <cstdint>
namespace cg = cooperative_groups;
namespace pg8 {
#define PG8_LAS __attribute__((address_space(3)))
typedef unsigned short bf16_t;
typedef short bf16x8 __attribute__((ext_vector_type(8)));
typedef float f32x4 __attribute__((ext_vector_type(4)));
typedef unsigned u32x4 __attribute__((ext_vector_type(4)));
constexpr int BM = 256, BK = 64, HALF = 128, HTB = HALF * BK * 2  , STAGE_BYTES = 8 * HTB, NXCD = 8, WGM = 8;

__host__ __device__ __forceinline__ int lds_byte(int r, int c) { const int st = (r >> 4) * 2 + (c >> 5), rr = r & 15, cc = c & 31, ob = rr * 64 + cc * 2; return st * 1024 + (ob ^ (((ob >> 9) & 1) << 5)); }
__host__ __device__ __forceinline__ void stage_rc(int b, int& R, int& C) { const int st = b / 1024, sb = b % 1024, swz = sb ^ (((sb >> 9) & 1) << 5); R = (st >> 1) * 16 + swz / 64; C = (st & 1) * 32 + (swz % 64) / 2; }
__host__ __device__ __forceinline__ int perm32(int rho) { const int n = rho >> 4, i = rho & 15; return 8 * (i >> 2) + 4 * n + (i & 3); }

struct Unit { int pm, pn; };
struct Gemm { const bf16_t* A; const bf16_t* Bt; int M, N, K; };

struct StaticOrder {
    int nM, nN, nwg, G, c;
    __host__ __device__ void init(int M, int N, int G_, int c_) { nM = M / BM; nN = N / BM; nwg = nM * nN; G = G_; c = c_; }
    __host__ __device__ bool next(int i, Unit& u) const {
        const long L = (long)i * G + c; if (L >= nwg) return false;
        int wgid = (int)L; { const int q = nwg / NXCD, r = nwg % NXCD, xcd = wgid % NXCD, off = wgid / NXCD; wgid = (xcd < r ? xcd * (q + 1) : r * (q + 1) + (xcd - r) * q) + off; }
        const int nig = WGM * nN, gid = wgid / nig, fm = gid * WGM, gsz = (nM - fm) < WGM ? (nM - fm) : WGM;
        u.pm = fm + ((wgid % nig) % gsz); u.pn = (wgid % nig) / gsz; return true;
    }
    __device__ __forceinline__ void a_ready(const Unit&) const {}
    __device__ __forceinline__ void done(const Unit&) const {}
};

__device__ __forceinline__ unsigned cvt_pk_bf16(float lo, float hi) { unsigned r; asm volatile("v_cvt_pk_bf16_f32 %0, %1, %2" : "=v"(r) : "v"(lo), "v"(hi)); return r; }
typedef float f32x2 __attribute__((ext_vector_type(2)));
template <int ACT  > struct EpiBf16 {
    static constexpr bool PERM = true, AFTER_DRAIN = false;
    bf16_t* O; int ldc;
    __device__ __forceinline__ void operator()(const f32x4 (&acc)[2][2][4][2], const Unit& u, int wr, int wc, int fr, int fq) const {
        const int row0 = u.pm * BM + wr * 64 + fr; const int col0 = u.pn * BM + wc * 32 + 8 * fq;
#pragma unroll
        for (int ai = 0; ai < 2; ++ai)
#pragma unroll
            for (int m = 0; m < 4; ++m) { bf16_t* rowp = O + (size_t)(row0 + ai * HALF + m * 16) * ldc + col0;
#pragma unroll
                for (int bj = 0; bj < 2; ++bj) { f32x4 v0 = acc[ai][bj][m][0], v1 = acc[ai][bj][m][1];
                    if (ACT == 2) {
#pragma unroll
                        for (int j = 0; j < 4; ++j) { const float a = fmaxf(v0[j], 0.f), b = fmaxf(v1[j], 0.f); v0[j] = a * a; v1[j] = b * b; } }
                    u32x4 w; w.x = cvt_pk_bf16(v0[0], v0[1]); w.y = cvt_pk_bf16(v0[2], v0[3]); w.z = cvt_pk_bf16(v1[0], v1[1]); w.w = cvt_pk_bf16(v1[2], v1[3]);
                    *(u32x4*)(rowp + bj * HALF) = w; } }
    }
};
struct EpiResGate {
    static constexpr bool PERM = false, AFTER_DRAIN = false;
    const float* base; float* out; const float* gate; int rows_per_batch, gate_stride;
    __device__ __forceinline__ void operator()(const f32x4 (&acc)[2][2][4][2], const Unit& u, int wr, int wc, int fr, int fq) const {
        const int row0 = u.pm * BM + wr * 64 + fr, col0 = u.pn * BM + wc * 32 + 4 * fq;
        const float* gp = gate + (size_t)((u.pm * BM) / rows_per_batch) * gate_stride + col0;
        f32x4 gv[2][2];
#pragma unroll
        for (int bj = 0; bj < 2; ++bj)
#pragma unroll
            for (int n = 0; n < 2; ++n) gv[bj][n] = *(const f32x4*)(gp + bj * HALF + n * 16);
#pragma unroll
        for (int ai = 0; ai < 2; ++ai)
#pragma unroll
            for (int m = 0; m < 4; ++m) { const size_t off = (size_t)(row0 + ai * HALF + m * 16) * 1024 + col0;
#pragma unroll
                for (int bj = 0; bj < 2; ++bj)
#pragma unroll
                    for (int n = 0; n < 2; ++n) { const f32x4 bs = *(const f32x4*)(base + off + bj * HALF + n * 16); *(f32x4*)(out + off + bj * HALF + n * 16) = bs + gv[bj][n] * acc[ai][bj][m][n]; }
                asm volatile("" ::: "memory"); }
    }
};
template <class Epi, class Sched, bool ALIGN_EPI = false, bool SP2 = false>
__device__ __forceinline__ void gemm_phase(PG8_LAS unsigned char* lds, const Gemm g, const Sched& S, const Epi& E) {
    const int tid = threadIdx.x, wid = __builtin_amdgcn_readfirstlane(tid >> 6), lane = tid & 63, wr = wid >> 2, wc = wid & 3, fr = lane & 15, fq = lane >> 4;
    const int K = g.K, nt = K / BK;
    unsigned voffA[2], voffB[2];
#pragma unroll
    for (int i = 0; i < 2; ++i) { int R, C; stage_rc(tid * 16 + i * 8192, R, C); const int Rb = Epi::PERM ? ((R & ~31) + perm32(R & 31)) : R;
        voffA[i] = (unsigned)(R * K + C) * 2u; voffB[i] = (unsigned)(Rb * K + C) * 2u; }
    const size_t kstep = (size_t)(BK * 2);
    const size_t hstep = (size_t)HALF * K * 2;
    const size_t tstep = 2 * hstep;
    const unsigned ldsw = (unsigned)wid * 1024u;
    const int aoff = lds_byte(wr * 64 + fr, fq * 8), boff = lds_byte(wc * 32 + fr, fq * 8);
#define PG8_SA(b, h) (((b) * 2 + (h)) * HTB)
#define PG8_SB(b, h) ((4 + (b) * 2 + (h)) * HTB)
#define PG8_STAGE(bufoff, gbase, voff) do { _Pragma("unroll") for (int _i = 0; _i < 2; ++_i) \
        __builtin_amdgcn_global_load_lds((const unsigned*)((const char*)(gbase) + (voff)[_i]), (PG8_LAS unsigned*)(lds + (bufoff) + ldsw + _i * 8192), 16, 0, 0); } while (0)
#define PG8_LDA(dst, b, h) do { _Pragma("unroll") for (int m = 0; m < 4; ++m) _Pragma("unroll") for (int k = 0; k < 2; ++k) dst[m][k] = *(const PG8_LAS bf16x8*)(lds + PG8_SA(b, h) + aoff + m * 2048 + k * 1024); } while (0)
#define PG8_LDB(dst, b, h) do { _Pragma("unroll") for (int n = 0; n < 2; ++n) _Pragma("unroll") for (int k = 0; k < 2; ++k) dst[n][k] = *(const PG8_LAS bf16x8*)(lds + PG8_SB(b, h) + boff + n * 2048 + k * 1024); } while (0)
#define PG8_MMA(ai, bj, At, Bt) do { __builtin_amdgcn_s_setprio(1); _Pragma("unroll") for (int m = 0; m < 4; ++m) _Pragma("unroll") for (int n = 0; n < 2; ++n) _Pragma("unroll") for (int k = 0; k < 2; ++k) \
        acc[ai][bj][m][n] = __builtin_amdgcn_mfma_f32_16x16x32_bf16(Bt[n][k], At[m][k], acc[ai][bj][m][n], 0, 0, 0); __builtin_amdgcn_s_setprio(0); } while (0)
#define PG8_WAIT_V(n) asm volatile("s_waitcnt vmcnt(" #n ")" ::: "memory")
#define PG8_WAIT_L(n) asm volatile("s_waitcnt lgkmcnt(" #n ")" ::: "memory")
#define PG8_BAR __builtin_amdgcn_s_barrier()
#define PG8_SCHED __builtin_amdgcn_sched_barrier(0)
    Unit cur, nxt; int ui = 0;
    if (!S.next(0, cur)) return;
    f32x4 acc[2][2][4][2];
#pragma unroll
    for (int a = 0; a < 2; ++a)
#pragma unroll
        for (int b = 0; b < 2; ++b)
#pragma unroll
            for (int m = 0; m < 4; ++m)
#pragma unroll
                for (int n = 0; n < 2; ++n) acc[a][b][m][n] = (f32x4){0.f, 0.f, 0.f, 0.f};
    bf16x8 At[4][2], B0[2][2], B1[2][2];
    const char* cA = (const char*)g.A + (size_t)cur.pm * tstep; const char* cB = (const char*)g.Bt + (size_t)cur.pn * tstep;
    S.a_ready(cur);
    if constexpr (SP2) {
        PG8_STAGE(PG8_SB(0, 0), cB, voffB); PG8_STAGE(PG8_SB(0, 1), cB + hstep, voffB); PG8_STAGE(PG8_SA(0, 0), cA, voffA); PG8_STAGE(PG8_SA(0, 1), cA + hstep, voffA);
        if (wr == 1) PG8_BAR;
        PG8_WAIT_V(2); PG8_BAR;
        PG8_STAGE(PG8_SB(1, 0), cB + kstep, voffB); PG8_STAGE(PG8_SA(1, 0), cA + kstep, voffA); PG8_STAGE(PG8_SB(1, 1), cB + hstep + kstep, voffB);
        PG8_WAIT_V(6); PG8_BAR;
    } else {
        PG8_STAGE(PG8_SB(0, 0), cB, voffB); PG8_STAGE(PG8_SA(0, 0), cA, voffA); PG8_STAGE(PG8_SB(0, 1), cB + hstep, voffB); PG8_STAGE(PG8_SA(0, 1), cA + hstep, voffA);
        if (wr == 1) PG8_BAR;
        PG8_WAIT_V(4); PG8_BAR;
        PG8_STAGE(PG8_SB(1, 0), cB + kstep, voffB); PG8_STAGE(PG8_SA(1, 0), cA + kstep, voffA); PG8_STAGE(PG8_SB(1, 1), cB + hstep + kstep, voffB);
        PG8_WAIT_V(6); PG8_BAR;
    }
    for (;;) {
        const bool has_next = S.next(ui + 1, nxt);
        const char* nA = has_next ? (const char*)g.A + (size_t)nxt.pm * tstep : cA; const char* nB = has_next ? (const char*)g.Bt + (size_t)nxt.pn * tstep : cB;
        for (int t = 0; t < nt; t += 2) {
            const bool last = (t == nt - 2);
            const char* a1 = cA + (size_t)(t + 1) * kstep;
            const char* a2 = last ? nA : cA + (size_t)(t + 2) * kstep; const char* b2 = last ? nB : cB + (size_t)(t + 2) * kstep;
            const char* a3 = a2 + kstep; const char* b3 = b2 + kstep;
            if (last && has_next) S.a_ready(nxt);
            if constexpr (SP2) {
            PG8_LDB(B0, 0, 0); PG8_LDB(B1, 0, 1); PG8_SCHED; PG8_LDA(At, 0, 0); PG8_STAGE(PG8_SA(1, 1), a1 + hstep, voffA);
            PG8_WAIT_V(8); PG8_WAIT_L(0); PG8_BAR; PG8_MMA(0, 0, At, B0); PG8_MMA(0, 1, At, B1); PG8_BAR; PG8_SCHED;
            PG8_LDA(At, 0, 1); PG8_STAGE(PG8_SB(0, 0), b2, voffB); PG8_STAGE(PG8_SB(0, 1), b2 + hstep, voffB); PG8_STAGE(PG8_SA(0, 0), a2, voffA);
            PG8_WAIT_V(8); PG8_WAIT_L(0); PG8_BAR; PG8_MMA(1, 0, At, B0); PG8_MMA(1, 1, At, B1); PG8_BAR; PG8_SCHED;
            PG8_LDB(B0, 1, 0); PG8_LDB(B1, 1, 1); PG8_SCHED; PG8_LDA(At, 1, 0); PG8_STAGE(PG8_SA(0, 1), a2 + hstep, voffA);
            PG8_WAIT_V(8); PG8_WAIT_L(0); PG8_BAR; PG8_MMA(0, 0, At, B0); PG8_MMA(0, 1, At, B1); PG8_BAR; PG8_SCHED;
            PG8_LDA(At, 1, 1); PG8_STAGE(PG8_SB(1, 0), b3, voffB); PG8_STAGE(PG8_SB(1, 1), b3 + hstep, voffB); PG8_STAGE(PG8_SA(1, 0), a3, voffA);
            PG8_WAIT_V(8); PG8_WAIT_L(0); PG8_BAR; PG8_MMA(1, 0, At, B0); PG8_MMA(1, 1, At, B1); PG8_BAR; PG8_SCHED;
            } else {
            PG8_LDB(B0, 0, 0); PG8_SCHED; PG8_LDA(At, 0, 0); PG8_STAGE(PG8_SA(1, 1), a1 + hstep, voffA);
            PG8_WAIT_L(8); PG8_BAR; PG8_WAIT_L(0); PG8_MMA(0, 0, At, B0); PG8_BAR; PG8_SCHED;
            PG8_LDB(B1, 0, 1); PG8_STAGE(PG8_SB(0, 0), b2, voffB);
            PG8_BAR; PG8_WAIT_L(0); PG8_MMA(0, 1, At, B1); PG8_BAR;
            PG8_LDA(At, 0, 1); PG8_STAGE(PG8_SA(0, 0), a2, voffA);
            PG8_BAR; PG8_WAIT_L(0); PG8_MMA(1, 0, At, B0); PG8_BAR; PG8_SCHED;
            PG8_STAGE(PG8_SB(0, 1), b2 + hstep, voffB);
            PG8_WAIT_V(6); PG8_BAR; PG8_MMA(1, 1, At, B1); PG8_BAR;
            PG8_LDB(B0, 1, 0); PG8_SCHED; PG8_LDA(At, 1, 0); PG8_STAGE(PG8_SA(0, 1), a2 + hstep, voffA);
            PG8_WAIT_L(8); PG8_BAR; PG8_WAIT_L(0); PG8_MMA(0, 0, At, B0); PG8_BAR; PG8_SCHED;
            PG8_LDB(B1, 1, 1); PG8_STAGE(PG8_SB(1, 0), b3, voffB);
            PG8_BAR; PG8_WAIT_L(0); PG8_MMA(0, 1, At, B1); PG8_BAR;
            PG8_LDA(At, 1, 1); PG8_STAGE(PG8_SA(1, 0), a3, voffA);
            PG8_BAR; PG8_WAIT_L(0); PG8_MMA(1, 0, At, B0); PG8_BAR; PG8_SCHED;
            PG8_STAGE(PG8_SB(1, 1), b3 + hstep, voffB);
            PG8_WAIT_V(6); PG8_BAR; PG8_MMA(1, 1, At, B1); PG8_BAR;
            }
        }
        if constexpr (ALIGN_EPI) { if (wr == 0) PG8_BAR; }
        if constexpr (!Epi::AFTER_DRAIN) { E(acc, cur, wr, wc, fr, fq); S.done(cur); }
        if (!has_next) break;
#pragma unroll
        for (int a = 0; a < 2; ++a)
#pragma unroll
            for (int b = 0; b < 2; ++b)
#pragma unroll
                for (int m = 0; m < 4; ++m)
#pragma unroll
                    for (int n = 0; n < 2; ++n) acc[a][b][m][n] = (f32x4){0.f, 0.f, 0.f, 0.f};
        cur = nxt; cA = nA; cB = nB; ++ui;
        if constexpr (ALIGN_EPI) { if (wr == 1) PG8_BAR; }
    }
    PG8_WAIT_V(0);
    if constexpr (!ALIGN_EPI) { if (wr == 0) PG8_BAR; }
    PG8_BAR;
    if constexpr (Epi::AFTER_DRAIN) { E.fused(acc, cur, wr, wc, fr, fq, lds, wid, lane); S.done(cur); }
#undef PG8_SA
#undef PG8_SB
#undef PG8_STAGE
#undef PG8_LDA
#undef PG8_LDB
#undef PG8_MMA
#undef PG8_WAIT_V
#undef PG8_WAIT_L
#undef PG8_BAR
#undef PG8_SCHED
}
}
#define LAS __attribute__((address_space(3)))
typedef unsigned short bf16;
typedef unsigned v4u __attribute__((ext_vector_type(4)));
typedef unsigned v2u __attribute__((ext_vector_type(2)));
typedef float f32x4 __attribute__((ext_vector_type(4)));
constexpr int D = 1024, BATCH = 16, SEQ = 2048, M = BATCH * SEQ;
constexpr int NHEADS = 16, HD = 64, NST = 128, CONVCH = 1536, MIXW = 1536, INW = 3088, NPROJ = 3072, FF = 4096, NMOD = 6 * D;
constexpr float EPS = 1e-5f;
constexpr int NWAVES = 8, NTHR = 512;
constexpr int LDS_BYTES = 147456;
constexpr size_t MiB = 1u << 20;
constexpr size_t WS_MOD = 0, WS_DT = 2 * MiB, WS_SSQ = 4 * MiB, WS_WIN = 6 * MiB, WS_WOUT = 12 * MiB, WS_WUP = 16 * MiB, WS_WDN = 24 * MiB;
constexpr size_t WS_XN = 32 * MiB, WS_PROJ = 96 * MiB, WS_CONV = 288 * MiB, WS_YMIX = 384 * MiB, WS_F = 96 * MiB, WS_END = 480 * MiB;

__device__ __forceinline__ unsigned f2bf(float f) { unsigned u = __float_as_uint(f); return (u + 0x7fffu + ((u >> 16) & 1u)) >> 16; }
__device__ __forceinline__ unsigned pk2(float lo, float hi) { unsigned r; asm("v_cvt_pk_bf16_f32 %0, %1, %2" : "=v"(r) : "v"(lo), "v"(hi)); return r; }
__device__ __forceinline__ float bflo(unsigned w) { return __uint_as_float(w << 16); }
__device__ __forceinline__ float bfhi(unsigned w) { return __uint_as_float(w & 0xffff0000u); }
__device__ __forceinline__ void unpack8(const v4u w, float (&f)[8]) { f[0] = bflo(w.x); f[1] = bfhi(w.x); f[2] = bflo(w.y); f[3] = bfhi(w.y); f[4] = bflo(w.z); f[5] = bfhi(w.z); f[6] = bflo(w.w); f[7] = bfhi(w.w); }
__device__ __forceinline__ v4u pack8(const float (&f)[8]) { v4u w; w.x = pk2(f[0], f[1]); w.y = pk2(f[2], f[3]); w.z = pk2(f[4], f[5]); w.w = pk2(f[6], f[7]); return w; }
__device__ __forceinline__ float wave_sum(float v) {
#pragma unroll
    for (int o = 1; o < 64; o <<= 1) v += __shfl_xor(v, o);
    return v;
}
__device__ __forceinline__ float silu_f(float v) { return v * __builtin_amdgcn_rcpf(1.f + __builtin_amdgcn_exp2f(-1.44269504f * v)); }
__device__ __forceinline__ float softplus_f(float v) { return fmaxf(v, 0.f) + log1pf(__expf(-fabsf(v))); }

struct Args { const float* in[19]; float* out; unsigned char* ws; int ph_lo, ph_hi; };

__device__ __forceinline__ void transpose_item(const float* W, int ldw, int col0, int K, bf16* WT, int row_off, LAS float* scr, int kb, int nb, int lane) {
    const int k0 = 64 * kb, n0 = 32 * nb;
#pragma unroll 8
    for (int i = 0; i < 32; ++i) { const int kk = 2 * i + (lane >> 5); scr[kk * 33 + (lane & 31)] = W[(size_t)(k0 + kk) * ldw + col0 + n0 + (lane & 31)]; }
    asm volatile("s_waitcnt lgkmcnt(0)" ::: "memory");
    const int c = lane & 7;
#pragma unroll
    for (int j = 0; j < 4; ++j) { const int n = (lane >> 3) + 8 * j; const LAS float* s = scr + (8 * c) * 33 + n;
        v4u o; o.x = pk2(s[0 * 33], s[1 * 33]); o.y = pk2(s[2 * 33], s[3 * 33]); o.z = pk2(s[4 * 33], s[5 * 33]); o.w = pk2(s[6 * 33], s[7 * 33]);
        *(v4u*)(WT + (size_t)(row_off + n0 + n) * K + k0 + 8 * c) = o; }
    asm volatile("s_waitcnt lgkmcnt(0)" ::: "memory");
}

__device__ __forceinline__ void p0_prologue(LAS unsigned char* lds, const Args& a, int G) {
    const int tid = threadIdx.x, lane = tid & 63, wave = tid >> 6;
    unsigned char* ws = a.ws;
    const float* w_in = a.in[5];
    bf16* WtIn = (bf16*)(ws + WS_WIN);
    {
        LAS float* wp = (LAS float*)lds;
        LAS float* win = (LAS float*)(lds + 65536);
        for (int it = blockIdx.x; it < 256; it += G) {
            const int g = it >> 6, k0 = (it & 63) * 16;
            const float* wpg = a.in[12] + (size_t)g * 16384;
            for (int i = tid; i < 16384; i += NTHR) wp[i] = wpg[i];
            for (int i = tid; i < 2048; i += NTHR) { const int kk = i >> 7, c = i & 127; win[i] = w_in[(size_t)(k0 + kk) * INW + g * 128 + c]; }
            __syncthreads();
            const int kk = tid >> 5, d4 = (tid & 31) * 4;
            f32x4 acc = {0.f, 0.f, 0.f, 0.f};
#pragma unroll 8
            for (int c = 0; c < 128; ++c) { const float av = win[kk * 128 + c]; const f32x4 w4 = *(const LAS f32x4*)(wp + c * 128 + d4); acc += av * w4; }
#pragma unroll
            for (int e = 0; e < 4; ++e) WtIn[(size_t)(g * 128 + d4 + e) * D + k0 + kk] = (bf16)f2bf(acc[e]);
            __syncthreads();
        }
    }
    {
        LAS float* cst = (LAS float*)lds;
        LAS float* part = (LAS float*)(lds + 65536);
        const float* cin = a.in[1]; const float* w_ada = a.in[2]; const float* b_ada = a.in[3];
        float* MOD = (float*)(ws + WS_MOD);
        if ((int)blockIdx.x < 192) {
            for (int i = tid; i < 16384; i += NTHR) { const int b = i >> 10, k = i & 1023; cst[k * 16 + b] = silu_f(cin[i]); }
            __syncthreads();
        }
        for (int it = blockIdx.x; it < 192; it += G) {
            const int col0 = it * 32, kh = lane >> 5, col = lane & 31, kbase = wave * 128 + kh * 64;
            float acc[16];
#pragma unroll
            for (int b = 0; b < 16; ++b) acc[b] = 0.f;
#pragma unroll 8
            for (int i = 0; i < 64; ++i) {
                const int k = kbase + i; const float wv = w_ada[(size_t)k * NMOD + col0 + col];
#pragma unroll
                for (int q = 0; q < 4; ++q) { const f32x4 c4 = *(const LAS f32x4*)(cst + k * 16 + 4 * q); acc[4 * q + 0] += c4.x * wv; acc[4 * q + 1] += c4.y * wv; acc[4 * q + 2] += c4.z * wv; acc[4 * q + 3] += c4.w * wv; }
            }
#pragma unroll
            for (int b = 0; b < 16; ++b) part[((wave * 2 + kh) * 16 + b) * 32 + col] = acc[b];
            __syncthreads();
            { const int b = tid >> 5, cc = tid & 31; float s = b_ada[col0 + cc];
#pragma unroll
              for (int p = 0; p < 16; ++p) s += part[(p * 16 + b) * 32 + cc];
              MOD[(size_t)b * NMOD + col0 + cc] = s; }
            __syncthreads();
        }
    }
    __syncthreads();
    {
        LAS float* scr = (LAS float*)(lds + wave * 16384);
        const int gw = blockIdx.x * NWAVES + wave, NGW = G * NWAVES;
        constexpr int I_IN = 16 * 80, I_OUT = 24 * 32, I_UP = 16 * 128, I_DN = 64 * 32;
        for (int it = gw; it < I_IN + I_OUT + I_UP + I_DN; it += NGW) {
            int r = it;
            if (r < I_IN) { transpose_item(w_in, INW, 512, D, WtIn, 512, scr, r / 80, r % 80, lane); continue; } r -= I_IN;
            if (r < I_OUT) { transpose_item(a.in[14], D, 0, MIXW, (bf16*)(ws + WS_WOUT), 0, scr, r / 32, r % 32, lane); continue; } r -= I_OUT;
            if (r < I_UP) { transpose_item(a.in[16], FF, 0, D, (bf16*)(ws + WS_WUP), 0, scr, r / 128, r % 128, lane); continue; } r -= I_UP;
            transpose_item(a.in[17], D, 0, FF, (bf16*)(ws + WS_WDN), 0, scr, r / 32, r % 32, lane);
        }
    }
}

template <bool WITH_DT>
__device__ __forceinline__ void normmod_phase(LAS unsigned char* lds, const float* src, const float* gvec, const float* MOD, int shift_ofs, int scale_ofs, bf16* XN,
                                              const float* w_in, const float* dt_bias, float* DT, int G) {
    const int tid = threadIdx.x, lane = tid & 63, wave = tid >> 6;
    LAS float* WdtL = (LAS float*)lds;
    if (WITH_DT) {
        for (int i = tid; i < 16384; i += NTHR) { const int k = i >> 4, h = i & 15; WdtL[h * 1024 + k] = w_in[(size_t)k * INW + NPROJ + h]; }
        __syncthreads();
    }
    const int gw = blockIdx.x * NWAVES + wave, NGW = G * NWAVES;
    for (int rg = gw; rg < M / 16; rg += NGW) {
        const int m0 = rg * 16, b = m0 / SEQ;
        const float* mp = MOD + (size_t)b * NMOD;
        f32x4 gs[4], sh[4];
#pragma unroll
        for (int j = 0; j < 4; ++j) { const int k = 4 * lane + 256 * j; const f32x4 g4 = *(const f32x4*)(gvec + k); const f32x4 sc = *(const f32x4*)(mp + scale_ofs + k); gs[j] = g4 * (sc + 1.0f); sh[j] = *(const f32x4*)(mp + shift_ofs + k); }
        for (int r = 0; r < 16; ++r) {
            const int m = m0 + r;
            const f32x4* xr = (const f32x4*)(src + (size_t)m * D) + lane;
            f32x4 v[4]; float ss = 0.f;
#pragma unroll
            for (int j = 0; j < 4; ++j) { v[j] = xr[64 * j]; ss += (v[j].x * v[j].x + v[j].y * v[j].y) + (v[j].z * v[j].z + v[j].w * v[j].w); }
            ss = wave_sum(ss);
            const float rinv = 1.0f / sqrtf(ss * (1.0f / D) + EPS);
#pragma unroll
            for (int j = 0; j < 4; ++j) v[j] = v[j] * rinv * gs[j] + sh[j];
            unsigned long long* o8 = (unsigned long long*)(XN + (size_t)m * D) + lane;
#pragma unroll
            for (int j = 0; j < 4; ++j) o8[64 * j] = (unsigned long long)pk2(v[j].x, v[j].y) | ((unsigned long long)pk2(v[j].z, v[j].w) << 32);
            if (WITH_DT) {
                float acc[16];
#pragma unroll
                for (int h = 0; h < 16; ++h) { float s = 0.f;
#pragma unroll
                    for (int j = 0; j < 4; ++j) { const f32x4 w4 = *(const LAS f32x4*)(WdtL + h * 1024 + 4 * lane + 256 * j); s += (v[j].x * w4.x + v[j].y * w4.y) + (v[j].z * w4.z + v[j].w * w4.w); }
                    acc[h] = s; if ((h & 3) == 3) asm volatile("" ::: "memory"); }
                float a8[8], a4[4], a2[2], a1;
                const bool u5 = (lane & 32) != 0, u4 = (lane & 16) != 0, u3 = (lane & 8) != 0, u2 = (lane & 4) != 0;
#pragma unroll
                for (int i = 0; i < 8; ++i) { const float keep = u5 ? acc[i + 8] : acc[i], send = u5 ? acc[i] : acc[i + 8]; a8[i] = keep + __shfl_xor(send, 32); }
#pragma unroll
                for (int i = 0; i < 4; ++i) { const float keep = u4 ? a8[i + 4] : a8[i], send = u4 ? a8[i] : a8[i + 4]; a4[i] = keep + __shfl_xor(send, 16); }
#pragma unroll
                for (int i = 0; i < 2; ++i) { const float keep = u3 ? a4[i + 2] : a4[i], send = u3 ? a4[i] : a4[i + 2]; a2[i] = keep + __shfl_xor(send, 8); }
                { const float keep = u2 ? a2[1] : a2[0], send = u2 ? a2[0] : a2[1]; a1 = keep + __shfl_xor(send, 4); }
                a1 += __shfl_xor(a1, 2); a1 += __shfl_xor(a1, 1);
                const int h = ((lane >> 5) & 1) * 8 + ((lane >> 4) & 1) * 4 + ((lane >> 3) & 1) * 2 + ((lane >> 2) & 1);
                if ((lane & 3) == 0) DT[(size_t)m * 16 + h] = softplus_f(a1 + dt_bias[h]);
            }
        }
    }
}

template <int TAPS, bool POOL>
__device__ __forceinline__ void fir_rows(const Args& a, int G, int cgi, int rsub) {
    const bf16* PROJ = (const bf16*)(a.ws + WS_PROJ);
    const int c0 = cgi * 8;
    const bf16* src = PROJ + (POOL ? 0 : 1536) + c0;
    bf16* dst = POOL ? (bf16*)(a.ws + WS_YMIX) + c0 : (bf16*)(a.ws + WS_CONV) + c0;
    const int dstride = POOL ? MIXW : CONVCH;
    const int w = POOL ? (2 << (c0 >> 7)) : 4;
    float pa[8], pb[4][8];
#pragma unroll
    for (int e = 0; e < 8; ++e) { pa[e] = POOL ? a.in[13][c0 + e] : a.in[7][c0 + e];
#pragma unroll
        for (int k = 0; k < 4; ++k) pb[k][e] = POOL ? 0.f : a.in[6][k * CONVCH + c0 + e]; }
    for (int blk = blockIdx.x; blk < M / 128; blk += G)
        for (int i = 0; i < 16; ++i) {
            const int m0 = blk * 128 + (i * 2 + rsub) * 4, s0 = m0 & (SEQ - 1);
            v4u L[TAPS + 3];
#pragma unroll
            for (int r = 0; r < TAPS + 3; ++r) { const int rel = r - (TAPS - 1);
                if (s0 + rel >= 0) L[r] = *(const v4u*)(src + (size_t)(m0 + rel) * NPROJ); else L[r] = (v4u){0u, 0u, 0u, 0u}; }
#pragma unroll
            for (int o = 0; o < 4; ++o) {
                float acc[8];
                if (POOL) {
                    const int nv = min(s0 + o + 1, w); const float inv = 1.0f / (float)nv;
#pragma unroll
                    for (int e = 0; e < 8; ++e) acc[e] = 0.f;
#pragma unroll
                    for (int j = 0; j < TAPS; ++j) { float t[8]; unpack8(L[TAPS - 1 + o - j], t); const float cj = (j < nv) ? 1.0f : 0.0f;
#pragma unroll
                        for (int e = 0; e < 8; ++e) acc[e] += cj * t[e]; }
                    float cur[8]; unpack8(L[TAPS - 1 + o], cur);
#pragma unroll
                    for (int e = 0; e < 8; ++e) acc[e] = (acc[e] * inv - cur[e]) * pa[e];
                } else {
#pragma unroll
                    for (int e = 0; e < 8; ++e) acc[e] = pa[e];
#pragma unroll
                    for (int k = 0; k < 4; ++k) { float t[8]; unpack8(L[o + k], t);
#pragma unroll
                        for (int e = 0; e < 8; ++e) acc[e] += pb[k][e] * t[e]; }
#pragma unroll
                    for (int e = 0; e < 8; ++e) acc[e] = silu_f(acc[e]);
                }
                *(v4u*)(dst + (size_t)(m0 + o) * dstride) = pack8(acc);
            }
        }
}
__device__ __forceinline__ void halo_phase(const Args& a, int G) {
    const int tid = threadIdx.x, cgp = tid & 255, rsub = tid >> 8;
    if (cgp < 64) fir_rows<16, true>(a, G, cgp, rsub); else fir_rows<4, false>(a, G, cgp - 64, rsub);
}

__device__ __forceinline__ void ssd_naive_phase(LAS unsigned char* lds, const Args& a, int G) {
    const int tid = threadIdx.x;
    LAS float* xs = (LAS float*)lds;
    LAS float* Bs = (LAS float*)(lds + 16384);
    LAS float* Cs = (LAS float*)(lds + 49152);
    LAS float* yb = (LAS float*)(lds + 81920);
    LAS float* dts = (LAS float*)(lds + 98304);
    LAS float* dAs = (LAS float*)(lds + 98304 + 256);
    const bf16* PROJ = (const bf16*)(a.ws + WS_PROJ); const bf16* CONV = (const bf16*)(a.ws + WS_CONV);
    bf16* YMIX = (bf16*)(a.ws + WS_YMIX); const float* DT = (const float*)(a.ws + WS_DT); float* SSQ = (float*)(a.ws + WS_SSQ);
    const int p = tid >> 3, nq = tid & 7, n0 = nq * 16;
    for (int it = blockIdx.x; it < BATCH * NHEADS; it += G) {
        const int b = it >> 4, hh = it & 15, g = hh >> 3;
        const float av = -__expf(a.in[9][hh]), dsk = a.in[10][hh];
        float h[16];
#pragma unroll
        for (int i = 0; i < 16; ++i) h[i] = 0.f;
        for (int ck = 0; ck < SEQ / 64; ++ck) {
            const size_t m0 = (size_t)b * SEQ + ck * 64;
            { const int t = tid >> 3, part = tid & 7; float f[8]; unpack8(*(const v4u*)(CONV + (m0 + t) * CONVCH + hh * 64 + part * 8), f);
#pragma unroll
              for (int e = 0; e < 8; ++e) xs[t * 64 + part * 8 + e] = f[e]; }
#pragma unroll
            for (int i = 0; i < 2; ++i) { const int piece = tid + i * NTHR, t = piece >> 4, part = piece & 15; float f[8];
                unpack8(*(const v4u*)(CONV + (m0 + t) * CONVCH + 1024 + g * 128 + part * 8), f);
#pragma unroll
                for (int e = 0; e < 8; ++e) Bs[t * 128 + part * 8 + e] = f[e];
                unpack8(*(const v4u*)(CONV + (m0 + t) * CONVCH + 1280 + g * 128 + part * 8), f);
#pragma unroll
                for (int e = 0; e < 8; ++e) Cs[t * 128 + part * 8 + e] = f[e]; }
            if (tid < 64) { const float dtv = DT[(m0 + tid) * 16 + hh]; dts[tid] = dtv; dAs[tid] = __expf(dtv * av); }
            __syncthreads();
            for (int t = 0; t < 64; ++t) {
                const float xr = xs[t * 64 + p], xv = xr * dts[t], dA = dAs[t];
                float yp = 0.f;
#pragma unroll
                for (int q = 0; q < 4; ++q) { const f32x4 b4 = *(const LAS f32x4*)(Bs + t * 128 + n0 + 4 * q), c4 = *(const LAS f32x4*)(Cs + t * 128 + n0 + 4 * q);
#pragma unroll
                    for (int e = 0; e < 4; ++e) { h[4 * q + e] = h[4 * q + e] * dA + xv * b4[e]; yp += h[4 * q + e] * c4[e]; } }
                yp += __shfl_xor(yp, 1); yp += __shfl_xor(yp, 2); yp += __shfl_xor(yp, 4);
                if (nq == 0) yb[t * 64 + p] = yp + dsk * xr;
            }
            __syncthreads();
            { const int t = tid >> 3, part = tid & 7; float z[8], y[8]; unpack8(*(const v4u*)(PROJ + (m0 + t) * NPROJ + 512 + hh * 64 + part * 8), z);
              float sq = 0.f;
#pragma unroll
              for (int e = 0; e < 8; ++e) { y[e] = yb[t * 64 + part * 8 + e] * silu_f(z[e]); sq += y[e] * y[e]; }
              sq += __shfl_xor(sq, 1); sq += __shfl_xor(sq, 2); sq += __shfl_xor(sq, 4);
              if (part == 0) SSQ[(m0 + t) * 16 + hh] = sq;
              *(v4u*)(YMIX + (m0 + t) * MIXW + 512 + hh * 64 + part * 8) = pack8(y); }
            __syncthreads();
        }
    }
}

typedef short s16x4 __attribute__((ext_vector_type(4)));
typedef short bf16x8 __attribute__((ext_vector_type(8)));
__device__ __forceinline__ bf16x8 frag_row(LAS unsigned char* base, int stride, int row0, int k0, int x, int y) { return *(const LAS bf16x8*)(base + (row0 + x) * stride + (k0 + 8 * y) * 2); }
__device__ __forceinline__ bf16x8 frag_tr(LAS unsigned char* base, int stride, int krow0, int col0, int lane) {
    const int y = lane >> 4, q = (lane >> 2) & 3, p = lane & 3;
    LAS unsigned char* a0 = base + (krow0 + 4 * y + q) * stride + (col0 + 4 * p) * 2;
    const s16x4 r0 = __builtin_amdgcn_ds_read_tr16_b64_v4i16((LAS s16x4*)a0);
    const s16x4 r1 = __builtin_amdgcn_ds_read_tr16_b64_v4i16((LAS s16x4*)(a0 + 16 * stride));
    return __builtin_shufflevector(r0, r1, 0, 1, 2, 3, 4, 5, 6, 7);
}
__device__ __forceinline__ void ssd_chunk_phase(LAS unsigned char* lds, const Args& a, int G) {
    const int tid = threadIdx.x, lane = tid & 63, w = __builtin_amdgcn_readfirstlane(tid >> 6), x = lane & 15, y = lane >> 4;
    constexpr int CS = 0, CSS = 272, BS = 34816, BSS = 288, XS = 71680, XSS = 160, XW = 92160, HB = 112640, HBS = 272, TAB = 130048;
    LAS float* t_acum = (LAS float*)(lds + TAB); LAS float* t_dt = t_acum + 128; LAS float* t_ea = t_acum + 256; LAS float* t_wl = t_acum + 384; LAS float* t_misc = t_acum + 512;
    const bf16* PROJ = (const bf16*)(a.ws + WS_PROJ); const bf16* CONV = (const bf16*)(a.ws + WS_CONV);
    bf16* YMIX = (bf16*)(a.ws + WS_YMIX); const float* DT = (const float*)(a.ws + WS_DT); float* SSQ = (float*)(a.ws + WS_SSQ);
    for (int it0 = blockIdx.x; it0 < BATCH * NHEADS; it0 += G) {
        const int xcd = it0 & 7, slot = it0 >> 3, qq = xcd * 4 + (slot >> 3), b = qq >> 1, g = qq & 1, hh = g * 8 + (slot & 7);
        const float av = -__expf(a.in[9][hh]), dsk = a.in[10][hh];
        f32x4 hst[4];
#pragma unroll
        for (int nt = 0; nt < 4; ++nt) hst[nt] = (f32x4){0.f, 0.f, 0.f, 0.f};
        v4u rc[4], rb[4], rx[2]; float d0 = 0.f, d1 = 0.f;
        const bf16* cbase = CONV + (size_t)b * SEQ * CONVCH;
#define SSD_LOAD(ck_) do { const bf16* cb_ = cbase + (size_t)(ck_) * 128 * CONVCH; \
            _Pragma("unroll") for (int i = 0; i < 4; ++i) { const int piece = tid + i * NTHR, row = piece >> 4, part = piece & 15; \
                rc[i] = *(const v4u*)(cb_ + (size_t)row * CONVCH + 1280 + g * 128 + part * 8); rb[i] = *(const v4u*)(cb_ + (size_t)row * CONVCH + 1024 + g * 128 + part * 8); } \
            _Pragma("unroll") for (int i = 0; i < 2; ++i) { const int piece = tid + i * NTHR, row = piece >> 3, part = piece & 7; rx[i] = *(const v4u*)(cb_ + (size_t)row * CONVCH + hh * 64 + part * 8); } \
            if (w == 0) { const size_t mm_ = (size_t)b * SEQ + (ck_) * 128 + 2 * lane; d0 = DT[mm_ * 16 + hh]; d1 = DT[(mm_ + 1) * 16 + hh]; } } while (0)
        SSD_LOAD(0);
        for (int ck = 0; ck < SEQ / 128; ++ck) {
            const size_t m0 = (size_t)b * SEQ + ck * 128;
            const int lt = (w < 4) ? w : 11 - w;
            const int l = 16 * lt + x;
            v2u rz[4];
#pragma unroll
            for (int pt = 0; pt < 4; ++pt) rz[pt] = *(const v2u*)(PROJ + (m0 + l) * NPROJ + 512 + hh * 64 + 16 * pt + 4 * y);
            if (w == 0) {
                const float a0 = d0 * av, a1 = d1 * av; float sc = a0 + a1;
#pragma unroll
                for (int o = 1; o < 64; o <<= 1) { const float t = __shfl_up(sc, o); if (lane >= o) sc += t; }
                const float c1 = sc, c0 = sc - a1, alast = __shfl(sc, 63);
                t_acum[2 * lane] = c0; t_acum[2 * lane + 1] = c1; t_dt[2 * lane] = d0; t_dt[2 * lane + 1] = d1;
                t_ea[2 * lane] = __expf(c0); t_ea[2 * lane + 1] = __expf(c1);
                t_wl[2 * lane] = d0 * __expf(alast - c0); t_wl[2 * lane + 1] = d1 * __expf(alast - c1);
                if (lane == 0) t_misc[0] = __expf(alast);
            }
#pragma unroll
            for (int i = 0; i < 4; ++i) { const int piece = tid + i * NTHR, row = piece >> 4, part = piece & 15;
                *(LAS v4u*)(lds + CS + row * CSS + part * 16) = rc[i]; *(LAS v4u*)(lds + BS + row * BSS + part * 16) = rb[i]; }
#pragma unroll
            for (int i = 0; i < 2; ++i) { const int piece = tid + i * NTHR, row = piece >> 3, part = piece & 7; *(LAS v4u*)(lds + XS + row * XSS + part * 16) = rx[i]; }
#pragma unroll
            for (int nt = 0; nt < 4; ++nt) { const int p = 16 * (w & 3) + x, n = 16 * (4 * (w >> 2) + nt) + 4 * y;
                *(LAS v2u*)(lds + HB + p * HBS + n * 2) = (v2u){pk2(hst[nt].x, hst[nt].y), pk2(hst[nt].z, hst[nt].w)}; }
            __syncthreads();
#pragma unroll
            for (int i = 0; i < 2; ++i) { const int piece = tid + i * NTHR, row = piece >> 3, part = piece & 7; const float wl = t_wl[row]; float f[8]; unpack8(rx[i], f);
#pragma unroll
                for (int e = 0; e < 8; ++e) f[e] *= wl;
                *(LAS v4u*)(lds + XW + row * XSS + part * 16) = pack8(f); }
            __syncthreads();
            if (ck + 1 < SEQ / 128) SSD_LOAD(ck + 1);
            bf16x8 cf[4];
#pragma unroll
            for (int ks = 0; ks < 4; ++ks) cf[ks] = frag_row(lds + CS, CSS, 16 * lt, 32 * ks, x, y);
            f32x4 sacc[8];
#pragma unroll
            for (int ts = 0; ts < 8; ++ts) { sacc[ts] = (f32x4){0.f, 0.f, 0.f, 0.f};
                if (ts <= lt) {
#pragma unroll
                for (int ks = 0; ks < 4; ++ks) sacc[ts] = __builtin_amdgcn_mfma_f32_16x16x32_bf16(frag_row(lds + BS, BSS, 16 * ts, 32 * ks, x, y), cf[ks], sacc[ts], 0, 0, 0); } }
            f32x4 yacc[4];
            const float ea_l = t_ea[l], ac_l = t_acum[l];
#pragma unroll
            for (int pt = 0; pt < 4; ++pt) { yacc[pt] = (f32x4){0.f, 0.f, 0.f, 0.f};
#pragma unroll
                for (int ks = 0; ks < 4; ++ks) yacc[pt] = __builtin_amdgcn_mfma_f32_16x16x32_bf16(frag_row(lds + HB, HBS, 16 * pt, 32 * ks, x, y), cf[ks], yacc[pt], 0, 0, 0);
                yacc[pt] = yacc[pt] * ea_l; }
#pragma unroll
            for (int ts = 0; ts < 8; ++ts) if (ts <= (lt | 1)) { const f32x4 as = *(const LAS f32x4*)(t_acum + 16 * ts + 4 * y), ds = *(const LAS f32x4*)(t_dt + 16 * ts + 4 * y); float gv[4];
#pragma unroll
                for (int e = 0; e < 4; ++e) { const int s = 16 * ts + 4 * y + e; const float ev = (s <= l) ? __expf(ac_l - as[e]) : 0.f; gv[e] = sacc[ts][e] * ev * ds[e]; }
                const int c = 32 * (ts >> 1) + 8 * y + 4 * (ts & 1);
                *(LAS v2u*)(lds + CS + l * CSS + c * 2) = (v2u){pk2(gv[0], gv[1]), pk2(gv[2], gv[3])}; }
            { const float cd = t_misc[0];
#pragma unroll
              for (int nt = 0; nt < 4; ++nt) hst[nt] = hst[nt] * cd;
#pragma unroll
              for (int ks = 0; ks < 4; ++ks) { const bf16x8 xf = frag_tr(lds + XW, XSS, 32 * ks, 16 * (w & 3), lane);
#pragma unroll
                  for (int nt = 0; nt < 4; ++nt) hst[nt] = __builtin_amdgcn_mfma_f32_16x16x32_bf16(frag_tr(lds + BS, BSS, 32 * ks, 16 * (4 * (w >> 2) + nt), lane), xf, hst[nt], 0, 0, 0); } }
#pragma unroll
            for (int ks = 0; ks < 4; ++ks) if (ks <= (lt >> 1)) { const bf16x8 gf = frag_row(lds + CS, CSS, 16 * lt, 32 * ks, x, y);
#pragma unroll
                for (int pt = 0; pt < 4; ++pt) yacc[pt] = __builtin_amdgcn_mfma_f32_16x16x32_bf16(frag_tr(lds + XS, XSS, 32 * ks, 16 * pt, lane), gf, yacc[pt], 0, 0, 0); }
            { const size_t m = m0 + l; float sq = 0.f;
#pragma unroll
              for (int pt = 0; pt < 4; ++pt) { const v2u xr = *(const LAS v2u*)(lds + XS + l * XSS + (16 * pt + 4 * y) * 2);
                  const float y0 = (yacc[pt].x + dsk * bflo(xr.x)) * silu_f(bflo(rz[pt].x)), y1 = (yacc[pt].y + dsk * bfhi(xr.x)) * silu_f(bfhi(rz[pt].x));
                  const float y2 = (yacc[pt].z + dsk * bflo(xr.y)) * silu_f(bflo(rz[pt].y)), y3 = (yacc[pt].w + dsk * bfhi(xr.y)) * silu_f(bfhi(rz[pt].y));
                  sq += (y0 * y0 + y1 * y1) + (y2 * y2 + y3 * y3);
                  *(v2u*)(YMIX + m * MIXW + 512 + hh * 64 + 16 * pt + 4 * y) = (v2u){pk2(y0, y1), pk2(y2, y3)}; }
              sq += __shfl_xor(sq, 16); sq += __shfl_xor(sq, 32);
              if (y == 0) SSQ[m * 16 + hh] = sq; }
            __syncthreads();
        }
#undef SSD_LOAD
    }
}

__device__ __forceinline__ void ssdnorm_phase(const Args& a, int G) {
    const int tid = threadIdx.x, rsub = tid >> 7, c8 = (tid & 127) * 8, g = c8 >> 9;
    bf16* YMIX = (bf16*)(a.ws + WS_YMIX); const float* SSQ = (const float*)(a.ws + WS_SSQ);
    float gsd[8];
#pragma unroll
    for (int e = 0; e < 8; ++e) gsd[e] = a.in[11][c8 + e];
    for (int r4 = blockIdx.x; r4 < M / 4; r4 += G) {
        const size_t m = (size_t)r4 * 4 + rsub;
        const f32x4 s0 = *(const f32x4*)(SSQ + m * 16 + g * 8), s1 = *(const f32x4*)(SSQ + m * 16 + g * 8 + 4);
        const float ss = ((s0.x + s0.y) + (s0.z + s0.w)) + ((s1.x + s1.y) + (s1.z + s1.w));
        const float rinv = 1.0f / sqrtf(ss * (1.0f / 512.0f) + EPS);
        float y[8]; v4u* pp = (v4u*)(YMIX + m * MIXW + 512 + c8); unpack8(*pp, y);
#pragma unroll
        for (int e = 0; e < 8; ++e) y[e] = y[e] * rinv * gsd[e];
        *pp = pack8(y);
    }
}

__device__ __forceinline__ void finalnorm_phase(const Args& a, int G) {
    const int tid = threadIdx.x, lane = tid & 63, wave = tid >> 6;
    const int gw = blockIdx.x * NWAVES + wave, NGW = G * NWAVES;
    f32x4 gf[4];
#pragma unroll
    for (int j = 0; j < 4; ++j) gf[j] = *(const f32x4*)(a.in[18] + 4 * lane + 256 * j);
    for (int m = gw; m < M; m += NGW) {
        f32x4* xr = (f32x4*)(a.out + (size_t)m * D) + lane;
        f32x4 v[4]; float ss = 0.f;
#pragma unroll
        for (int j = 0; j < 4; ++j) { v[j] = xr[64 * j]; ss += (v[j].x * v[j].x + v[j].y * v[j].y) + (v[j].z * v[j].z + v[j].w * v[j].w); }
        ss = wave_sum(ss);
        const float rinv = 1.0f / sqrtf(ss * (1.0f / D) + EPS);
#pragma unroll
        for (int j = 0; j < 4; ++j) xr[64 * j] = v[j] * rinv * gf[j];
    }
}

constexpr int NPHASES = 11;
__global__ void __launch_bounds__(NTHR, 2) fwd_kernel(Args args) {
    extern __shared__ __attribute__((aligned(16))) unsigned char lds_raw[];
    LAS unsigned char* lds = (LAS unsigned char*)lds_raw;
    cg::grid_group grid = cg::this_grid();
    const int G = gridDim.x, lo = args.ph_lo, hi = args.ph_hi;
    unsigned char* ws = args.ws;
    float* MOD = (float*)(ws + WS_MOD);
#ifndef PH_MASK
#define PH_MASK 0x7ff
#endif
#define IN(k) ((((PH_MASK) >> (k)) & 1) && lo <= (k) && (k) < hi)
#ifndef PROBE_DUP
#define PROBE_DUP -1
#endif
#define PH(k, ...) do { if (IN(k)) { __VA_ARGS__ if (PROBE_DUP == (k)) { grid.sync(); __VA_ARGS__ } } } while (0);
#define SEAM(k) do { if (IN(k) && IN((k) + 1)) grid.sync(); } while (0)
    PH(0, { p0_prologue(lds, args, G); }) SEAM(0);
    PH(1, { normmod_phase<true>(lds, args.in[0], args.in[4], MOD, 0, 1024, (bf16*)(ws + WS_XN), args.in[5], args.in[8], (float*)(ws + WS_DT), G); __syncthreads(); }) SEAM(1);
    PH(2, { pg8::Gemm g{(const bf16*)(ws + WS_XN), (const bf16*)(ws + WS_WIN), M, NPROJ, D}; pg8::StaticOrder S; S.init(M, NPROJ, G, (int)blockIdx.x);
        pg8::EpiBf16<0> E{(bf16*)(ws + WS_PROJ), NPROJ}; pg8::gemm_phase<pg8::EpiBf16<0>, pg8::StaticOrder, true, true>(lds, g, S, E); }) SEAM(2);
    PH(3, { halo_phase(args, G); }) SEAM(3);
    #ifdef SSD_NAIVE
    PH(4, { ssd_naive_phase(lds, args, G); }) SEAM(4);
#else
    PH(4, { ssd_chunk_phase(lds, args, G); }) SEAM(4);
#endif
    PH(5, { ssdnorm_phase(args, G); }) SEAM(5);
    PH(6, { pg8::Gemm g{(const bf16*)(ws + WS_YMIX), (const bf16*)(ws + WS_WOUT), M, D, MIXW}; pg8::StaticOrder S; S.init(M, D, G, (int)blockIdx.x);
        pg8::EpiResGate E{args.in[0], args.out, MOD + 2048, SEQ, NMOD}; pg8::gemm_phase<pg8::EpiResGate, pg8::StaticOrder, true, true>(lds, g, S, E); }) SEAM(6);
    PH(7, { normmod_phase<false>(lds, args.out, args.in[15], MOD, 3072, 4096, (bf16*)(ws + WS_XN), nullptr, nullptr, nullptr, G); }) SEAM(7);
    PH(8, { pg8::Gemm g{(const bf16*)(ws + WS_XN), (const bf16*)(ws + WS_WUP), M, FF, D}; pg8::StaticOrder S; S.init(M, FF, G, (int)blockIdx.x);
        pg8::EpiBf16<2> E{(bf16*)(ws + WS_F), FF}; pg8::gemm_phase<pg8::EpiBf16<2>, pg8::StaticOrder, true, true>(lds, g, S, E); }) SEAM(8);
    PH(9, { pg8::Gemm g{(const bf16*)(ws + WS_F), (const bf16*)(ws + WS_WDN), M, D, FF}; pg8::StaticOrder S; S.init(M, D, G, (int)blockIdx.x);
        pg8::EpiResGate E{args.out, args.out, MOD + 5120, SEQ, NMOD}; pg8::gemm_phase<pg8::EpiResGate, pg8::StaticOrder, true, true>(lds, g, S, E); }) SEAM(9);
    PH(10, { finalnorm_phase(args, G); })
#undef IN
#undef SEAM
}

#ifndef MK_ONE_LAUNCH
#define MK_ONE_LAUNCH 1
#endif
extern "C" void kernel_launch(void* const* d_in, const int* in_sizes, int n_in, void* d_out, int out_size, void* d_ws, size_t ws_size, hipStream_t stream) {
    static int grid = 0;
    if (grid == 0) {
        if (n_in != 19 || out_size != M * D || ws_size < WS_END) { fprintf(stderr, "kernel_launch: unexpected shapes (n_in %d, out %d, ws %zu)\n", n_in, out_size, ws_size); grid = -1; return; }
        int dev = 0, cus = 0, per_cu = 0;
        if (hipGetDevice(&dev) != hipSuccess || hipDeviceGetAttribute(&cus, hipDeviceAttributeMultiprocessorCount, dev) != hipSuccess) { grid = -1; return; }
        if (hipFuncSetAttribute((const void*)fwd_kernel, hipFuncAttributeMaxDynamicSharedMemorySize, LDS_BYTES) != hipSuccess) { fprintf(stderr, "kernel_launch: hipFuncSetAttribute failed\n"); grid = -1; return; }
        if (hipOccupancyMaxActiveBlocksPerMultiprocessor(&per_cu, (const void*)fwd_kernel, NTHR, LDS_BYTES) != hipSuccess || per_cu < 1) { fprintf(stderr, "kernel_launch: occupancy query says %d\n", per_cu); (void)hipGetLastError(); per_cu = 1; }
        grid = cus * per_cu;
        fprintf(stderr, "kernel_launch: grid %d (cus %d x %d)\n", grid, cus, per_cu);
    }
    if (grid < 0) return;
    Args a{};
    for (int i = 0; i < 19; ++i) a.in[i] = (const float*)d_in[i];
    a.out = (float*)d_out; a.ws = (unsigned char*)d_ws;
#if MK_ONE_LAUNCH
    a.ph_lo = 0; a.ph_hi = NPHASES;
    void* kargs[] = {&a};
    hipError_t e = hipLaunchCooperativeKernel((const void*)fwd_kernel, dim3(grid), dim3(NTHR), kargs, LDS_BYTES, stream);
    if (e != hipSuccess) fprintf(stderr, "kernel_launch: cooperative launch failed: %s (grid %d)\n", hipGetErrorString(e), grid);
#else
    for (int ph = 0; ph < NPHASES; ++ph) {
        a.ph_lo = ph; a.ph_hi = ph + 1;
        hipLaunchKernelGGL(fwd_kernel, dim3(grid), dim3(NTHR), LDS_BYTES, stream, a);
    }
#endif
}
```

```cpp
#include <hip/hip_runtime.h>
#include <hip/hip_cooperative_groups.h>
#include <cstdio>
#include <cstdint>
namespace cg = cooperative_groups;
namespace pg8 {
#define PG8_LAS __attribute__((address_space(3)))
typedef unsigned short bf16_t;
typedef short bf16x8 __attribute__((ext_vector_type(8)));
typedef float f32x4 __attribute__((ext_vector_type(4)));
typedef unsigned u32x4 __attribute__((ext_vector_type(4)));
constexpr int BM = 256, BK = 64, HALF = 128, HTB = HALF * BK * 2  , STAGE_BYTES = 8 * HTB, NXCD = 8, WGM = 8;

__host__ __device__ __forceinline__ int lds_byte(int r, int c) { const int st = (r >> 4) * 2 + (c >> 5), rr = r & 15, cc = c & 31, ob = rr * 64 + cc * 2; return st * 1024 + (ob ^ (((ob >> 9) & 1) << 5)); }
__host__ __device__ __forceinline__ void stage_rc(int b, int& R, int& C) { const int st = b / 1024, sb = b % 1024, swz = sb ^ (((sb >> 9) & 1) << 5); R = (st >> 1) * 16 + swz / 64; C = (st & 1) * 32 + (swz % 64) / 2; }
__host__ __device__ __forceinline__ int perm32(int rho) { const int n = rho >> 4, i = rho & 15; return 8 * (i >> 2) + 4 * n + (i & 3); }

struct Unit { int pm, pn; };
struct Gemm { const bf16_t* A; const bf16_t* Bt; int M, N, K; };

struct StaticOrder {
    int nM, nN, nwg, G, c;
    __host__ __device__ void init(int M, int N, int G_, int c_) { nM = M / BM; nN = N / BM; nwg = nM * nN; G = G_; c = c_; }
    __host__ __device__ bool next(int i, Unit& u) const {
        const long L = (long)i * G + c; if (L >= nwg) return false;
        int wgid = (int)L; { const int q = nwg / NXCD, r = nwg % NXCD, xcd = wgid % NXCD, off = wgid / NXCD; wgid = (xcd < r ? xcd * (q + 1) : r * (q + 1) + (xcd - r) * q) + off; }
        const int nig = WGM * nN, gid = wgid / nig, fm = gid * WGM, gsz = (nM - fm) < WGM ? (nM - fm) : WGM;
        u.pm = fm + ((wgid % nig) % gsz); u.pn = (wgid % nig) / gsz; return true;
    }
    __device__ __forceinline__ void a_ready(const Unit&) const {}
    __device__ __forceinline__ void done(const Unit&) const {}
};

struct SsdOrder : StaticOrder {
    const float* ssq; PG8_LAS unsigned char* lds; float eps;
    __device__ __forceinline__ void a_ready(const Unit& u) const {
        const int tid = threadIdx.x;
        if (tid < 256) { const f32x4* sp = (const f32x4*)(ssq + (size_t)(u.pm * BM + tid) * 16); const f32x4 a0 = sp[0], a1 = sp[1], b0 = sp[2], b1 = sp[3];
            const float s0 = ((a0[0] + a0[1]) + (a0[2] + a0[3])) + ((a1[0] + a1[1]) + (a1[2] + a1[3])), s1 = ((b0[0] + b0[1]) + (b0[2] + b0[3])) + ((b1[0] + b1[1]) + (b1[2] + b1[3]));
            const float r0 = 1.0f / sqrtf(s0 * (1.0f / 512.0f) + eps), r1 = 1.0f / sqrtf(s1 * (1.0f / 512.0f) + eps);
            PG8_LAS float* tab = (PG8_LAS float*)(lds + STAGE_BYTES); tab[tid * 2] = r0 / r1; tab[tid * 2 + 1] = r1; }
    }
};

__device__ __forceinline__ unsigned cvt_pk_bf16(float lo, float hi) { unsigned r; asm volatile("v_cvt_pk_bf16_f32 %0, %1, %2" : "=v"(r) : "v"(lo), "v"(hi)); return r; }
typedef float f32x2 __attribute__((ext_vector_type(2)));
template <int ACT  > struct EpiBf16 {
    static constexpr bool PERM = true, AFTER_DRAIN = false, KSCALE = false;
    bf16_t* O; int ldc;
    __device__ __forceinline__ void operator()(const f32x4 (&acc)[2][2][4][2], const Unit& u, int wr, int wc, int fr, int fq) const {
        const int row0 = u.pm * BM + wr * 64 + fr; const int col0 = u.pn * BM + wc * 32 + 8 * fq;
#pragma unroll
        for (int ai = 0; ai < 2; ++ai)
#pragma unroll
            for (int m = 0; m < 4; ++m) { bf16_t* rowp = O + (size_t)(row0 + ai * HALF + m * 16) * ldc + col0;
#pragma unroll
                for (int bj = 0; bj < 2; ++bj) { f32x4 v0 = acc[ai][bj][m][0], v1 = acc[ai][bj][m][1];
                    if (ACT == 2) {
#pragma unroll
                        for (int j = 0; j < 4; ++j) { const float a = fmaxf(v0[j], 0.f), b = fmaxf(v1[j], 0.f); v0[j] = a * a; v1[j] = b * b; } }
                    u32x4 w; w.x = cvt_pk_bf16(v0[0], v0[1]); w.y = cvt_pk_bf16(v0[2], v0[3]); w.z = cvt_pk_bf16(v1[0], v1[1]); w.w = cvt_pk_bf16(v1[2], v1[3]);
                    *(u32x4*)(rowp + bj * HALF) = w; } }
    }
};
struct EpiResGate {
    static constexpr bool PERM = false, AFTER_DRAIN = false, KSCALE = false;
    const float* base; float* out; const float* gate; int rows_per_batch, gate_stride;
    __device__ __forceinline__ void operator()(const f32x4 (&acc)[2][2][4][2], const Unit& u, int wr, int wc, int fr, int fq) const {
        const int row0 = u.pm * BM + wr * 64 + fr, col0 = u.pn * BM + wc * 32 + 4 * fq;
        const float* gp = gate + (size_t)((u.pm * BM) / rows_per_batch) * gate_stride + col0;
        f32x4 gv[2][2];
#pragma unroll
        for (int bj = 0; bj < 2; ++bj)
#pragma unroll
            for (int n = 0; n < 2; ++n) gv[bj][n] = *(const f32x4*)(gp + bj * HALF + n * 16);
#pragma unroll
        for (int ai = 0; ai < 2; ++ai)
#pragma unroll
            for (int m = 0; m < 4; ++m) { const size_t off = (size_t)(row0 + ai * HALF + m * 16) * 1024 + col0;
#pragma unroll
                for (int bj = 0; bj < 2; ++bj)
#pragma unroll
                    for (int n = 0; n < 2; ++n) { const f32x4 bs = *(const f32x4*)(base + off + bj * HALF + n * 16); *(f32x4*)(out + off + bj * HALF + n * 16) = bs + gv[bj][n] * acc[ai][bj][m][n]; }
                asm volatile("" ::: "memory"); }
    }
};
struct EpiResGate2 {
    static constexpr bool PERM = false, AFTER_DRAIN = false, KSCALE = true; static constexpr int KS_T0 = 6, KS_T1 = 14;
    __device__ __forceinline__ void kscale(f32x4 (&acc)[2][2][4][2], PG8_LAS unsigned char* lds, int which, int wr, int fr) const {
        const PG8_LAS float* tab = (const PG8_LAS float*)(lds + STAGE_BYTES);
#pragma unroll
        for (int ai = 0; ai < 2; ++ai)
#pragma unroll
            for (int m = 0; m < 4; ++m) { const float f = tab[(ai * HALF + wr * 64 + m * 16 + fr) * 2 + which];
#pragma unroll
                for (int bj = 0; bj < 2; ++bj)
#pragma unroll
                    for (int n = 0; n < 2; ++n) acc[ai][bj][m][n] = acc[ai][bj][m][n] * f; }
    }
    const float* base; float* out; const float* gate; const float* gvec; const float* scale; bf16_t* xn; float* rowp; int rows_per_batch, gate_stride;
    __device__ __forceinline__ void operator()(const f32x4 (&acc)[2][2][4][2], const Unit& u, int wr, int wc, int fr, int fq) const {
        const int row0 = u.pm * BM + wr * 64 + fr, col0 = u.pn * BM + wc * 32 + 4 * fq;
        const size_t bofs = (size_t)((u.pm * BM) / rows_per_batch) * gate_stride + col0;
        f32x4 gv[2][2], gs[2][2];
#pragma unroll
        for (int bj = 0; bj < 2; ++bj)
#pragma unroll
            for (int n = 0; n < 2; ++n) { gv[bj][n] = *(const f32x4*)(gate + bofs + bj * HALF + n * 16);
                gs[bj][n] = *(const f32x4*)(gvec + col0 + bj * HALF + n * 16) * (*(const f32x4*)(scale + bofs + bj * HALF + n * 16) + 1.0f); }
#pragma unroll
        for (int ai = 0; ai < 2; ++ai)
#pragma unroll
            for (int m = 0; m < 4; ++m) { const int row = row0 + ai * HALF + m * 16; const size_t off = (size_t)row * 1024 + col0; float ss = 0.f;
#pragma unroll
                for (int bj = 0; bj < 2; ++bj)
#pragma unroll
                    for (int n = 0; n < 2; ++n) { const f32x4 bs = *(const f32x4*)(base + off + bj * HALF + n * 16); const f32x4 h = bs + gv[bj][n] * acc[ai][bj][m][n];
                        *(f32x4*)(out + off + bj * HALF + n * 16) = h; ss += (h[0] * h[0] + h[1] * h[1]) + (h[2] * h[2] + h[3] * h[3]);
                        const f32x4 av = h * gs[bj][n]; typedef unsigned u32x2v __attribute__((ext_vector_type(2))); u32x2v wv; wv.x = cvt_pk_bf16(av[0], av[1]); wv.y = cvt_pk_bf16(av[2], av[3]);
                        *(u32x2v*)(xn + off + bj * HALF + n * 16) = wv; }
                ss += __shfl_xor(ss, 16); ss += __shfl_xor(ss, 32);
                if (fq == 0) rowp[(size_t)row * 16 + u.pn * 4 + wc] = ss;
                asm volatile("" ::: "memory"); }
    }
};
struct EpiUp {
    static constexpr bool PERM = true, AFTER_DRAIN = false, KSCALE = false;
    bf16_t* O; int ldc; const float* rowp; const float* shw; int rows_per_batch; float inv_d, eps;
    __device__ __forceinline__ void operator()(const f32x4 (&acc)[2][2][4][2], const Unit& u, int wr, int wc, int fr, int fq) const {
        const int row0 = u.pm * BM + wr * 64 + fr; const int col0 = u.pn * BM + wc * 32 + 8 * fq;
        const float* sp = shw + (size_t)((u.pm * BM) / rows_per_batch) * ldc + col0;
        f32x4 bv[2][2];
#pragma unroll
        for (int bj = 0; bj < 2; ++bj)
#pragma unroll
            for (int n = 0; n < 2; ++n) bv[bj][n] = *(const f32x4*)(sp + bj * HALF + 4 * n);
#pragma unroll
        for (int ai = 0; ai < 2; ++ai)
#pragma unroll
            for (int m = 0; m < 4; ++m) { const int row = row0 + ai * HALF + m * 16; bf16_t* rowp_o = O + (size_t)row * ldc + col0;
                const f32x4* rp = (const f32x4*)(rowp + (size_t)row * 16); const f32x4 p0 = rp[0], p1 = rp[1], p2 = rp[2], p3 = rp[3];
                const float ss = (((p0[0] + p0[1]) + (p0[2] + p0[3])) + ((p1[0] + p1[1]) + (p1[2] + p1[3]))) + (((p2[0] + p2[1]) + (p2[2] + p2[3])) + ((p3[0] + p3[1]) + (p3[2] + p3[3])));
                const float rinv = 1.0f / sqrtf(ss * inv_d + eps);
#pragma unroll
                for (int bj = 0; bj < 2; ++bj) { f32x4 v0 = acc[ai][bj][m][0] * rinv + bv[bj][0], v1 = acc[ai][bj][m][1] * rinv + bv[bj][1];
#pragma unroll
                    for (int j = 0; j < 4; ++j) { const float a = fmaxf(v0[j], 0.f), b = fmaxf(v1[j], 0.f); v0[j] = a * a; v1[j] = b * b; }
                    u32x4 w; w.x = cvt_pk_bf16(v0[0], v0[1]); w.y = cvt_pk_bf16(v0[2], v0[3]); w.z = cvt_pk_bf16(v1[0], v1[1]); w.w = cvt_pk_bf16(v1[2], v1[3]);
                    *(u32x4*)(rowp_o + bj * HALF) = w; } }
    }
};
template <class Epi, class Sched, bool ALIGN_EPI = false, bool SP2 = false>
__device__ __forceinline__ void gemm_phase(PG8_LAS unsigned char* lds, const Gemm g, const Sched& S, const Epi& E) {
    const int tid = threadIdx.x, wid = __builtin_amdgcn_readfirstlane(tid >> 6), lane = tid & 63, wr = wid >> 2, wc = wid & 3, fr = lane & 15, fq = lane >> 4;
    const int K = g.K, nt = K / BK;
    unsigned voffA[2], voffB[2];
#pragma unroll
    for (int i = 0; i < 2; ++i) { int R, C; stage_rc(tid * 16 + i * 8192, R, C); const int Rb = Epi::PERM ? ((R & ~31) + perm32(R & 31)) : R;
        voffA[i] = (unsigned)(R * K + C) * 2u; voffB[i] = (unsigned)(Rb * K + C) * 2u; }
    const size_t kstep = (size_t)(BK * 2);
    const size_t hstep = (size_t)HALF * K * 2;
    const size_t tstep = 2 * hstep;
    const unsigned ldsw = (unsigned)wid * 1024u;
    const int aoff = lds_byte(wr * 64 + fr, fq * 8), boff = lds_byte(wc * 32 + fr, fq * 8);
#define PG8_SA(b, h) (((b) * 2 + (h)) * HTB)
#define PG8_SB(b, h) ((4 + (b) * 2 + (h)) * HTB)
#define PG8_STAGE(bufoff, gbase, voff) do { _Pragma("unroll") for (int _i = 0; _i < 2; ++_i) \
        __builtin_amdgcn_global_load_lds((const unsigned*)((const char*)(gbase) + (voff)[_i]), (PG8_LAS unsigned*)(lds + (bufoff) + ldsw + _i * 8192), 16, 0, 0); } while (0)
#define PG8_LDA(dst, b, h) do { _Pragma("unroll") for (int m = 0; m < 4; ++m) _Pragma("unroll") for (int k = 0; k < 2; ++k) dst[m][k] = *(const PG8_LAS bf16x8*)(lds + PG8_SA(b, h) + aoff + m * 2048 + k * 1024); } while (0)
#define PG8_LDB(dst, b, h) do { _Pragma("unroll") for (int n = 0; n < 2; ++n) _Pragma("unroll") for (int k = 0; k < 2; ++k) dst[n][k] = *(const PG8_LAS bf16x8*)(lds + PG8_SB(b, h) + boff + n * 2048 + k * 1024); } while (0)
#define PG8_MMA(ai, bj, At, Bt) do { __builtin_amdgcn_s_setprio(1); _Pragma("unroll") for (int m = 0; m < 4; ++m) _Pragma("unroll") for (int n = 0; n < 2; ++n) _Pragma("unroll") for (int k = 0; k < 2; ++k) \
        acc[ai][bj][m][n] = __builtin_amdgcn_mfma_f32_16x16x32_bf16(Bt[n][k], At[m][k], acc[ai][bj][m][n], 0, 0, 0); __builtin_amdgcn_s_setprio(0); } while (0)
#define PG8_WAIT_V(n) asm volatile("s_waitcnt vmcnt(" #n ")" ::: "memory")
#define PG8_WAIT_L(n) asm volatile("s_waitcnt lgkmcnt(" #n ")" ::: "memory")
#define PG8_BAR __builtin_amdgcn_s_barrier()
#define PG8_SCHED __builtin_amdgcn_sched_barrier(0)
    Unit cur, nxt; int ui = 0;
    if (!S.next(0, cur)) return;
    f32x4 acc[2][2][4][2];
#pragma unroll
    for (int a = 0; a < 2; ++a)
#pragma unroll
        for (int b = 0; b < 2; ++b)
#pragma unroll
            for (int m = 0; m < 4; ++m)
#pragma unroll
                for (int n = 0; n < 2; ++n) acc[a][b][m][n] = (f32x4){0.f, 0.f, 0.f, 0.f};
    bf16x8 At[4][2], B0[2][2], B1[2][2];
    const char* cA = (const char*)g.A + (size_t)cur.pm * tstep; const char* cB = (const char*)g.Bt + (size_t)cur.pn * tstep;
    S.a_ready(cur);
    if constexpr (SP2) {
        PG8_STAGE(PG8_SB(0, 0), cB, voffB); PG8_STAGE(PG8_SB(0, 1), cB + hstep, voffB); PG8_STAGE(PG8_SA(0, 0), cA, voffA); PG8_STAGE(PG8_SA(0, 1), cA + hstep, voffA);
        if (wr == 1) PG8_BAR;
        PG8_WAIT_V(2); PG8_BAR;
        PG8_STAGE(PG8_SB(1, 0), cB + kstep, voffB); PG8_STAGE(PG8_SA(1, 0), cA + kstep, voffA); PG8_STAGE(PG8_SB(1, 1), cB + hstep + kstep, voffB);
        PG8_WAIT_V(6); PG8_BAR;
    } else {
        PG8_STAGE(PG8_SB(0, 0), cB, voffB); PG8_STAGE(PG8_SA(0, 0), cA, voffA); PG8_STAGE(PG8_SB(0, 1), cB + hstep, voffB); PG8_STAGE(PG8_SA(0, 1), cA + hstep, voffA);
        if (wr == 1) PG8_BAR;
        PG8_WAIT_V(4); PG8_BAR;
        PG8_STAGE(PG8_SB(1, 0), cB + kstep, voffB); PG8_STAGE(PG8_SA(1, 0), cA + kstep, voffA); PG8_STAGE(PG8_SB(1, 1), cB + hstep + kstep, voffB);
        PG8_WAIT_V(6); PG8_BAR;
    }
    for (;;) {
        const bool has_next = S.next(ui + 1, nxt);
        const char* nA = has_next ? (const char*)g.A + (size_t)nxt.pm * tstep : cA; const char* nB = has_next ? (const char*)g.Bt + (size_t)nxt.pn * tstep : cB;
        for (int t = 0; t < nt; t += 2) {
            const bool last = (t == nt - 2);
            const char* a1 = cA + (size_t)(t + 1) * kstep;
            const char* a2 = last ? nA : cA + (size_t)(t + 2) * kstep; const char* b2 = last ? nB : cB + (size_t)(t + 2) * kstep;
            const char* a3 = a2 + kstep; const char* b3 = b2 + kstep;
            if (last && has_next) S.a_ready(nxt);
            if constexpr (SP2) {
            PG8_LDB(B0, 0, 0); PG8_LDB(B1, 0, 1); PG8_SCHED; PG8_LDA(At, 0, 0); PG8_STAGE(PG8_SA(1, 1), a1 + hstep, voffA);
            PG8_WAIT_V(8); PG8_WAIT_L(0); PG8_BAR; PG8_MMA(0, 0, At, B0); PG8_MMA(0, 1, At, B1); PG8_BAR; PG8_SCHED;
            PG8_LDA(At, 0, 1); PG8_STAGE(PG8_SB(0, 0), b2, voffB); PG8_STAGE(PG8_SB(0, 1), b2 + hstep, voffB); PG8_STAGE(PG8_SA(0, 0), a2, voffA);
            PG8_WAIT_V(8); PG8_WAIT_L(0); PG8_BAR; PG8_MMA(1, 0, At, B0); PG8_MMA(1, 1, At, B1); PG8_BAR; PG8_SCHED;
            PG8_LDB(B0, 1, 0); PG8_LDB(B1, 1, 1); PG8_SCHED; PG8_LDA(At, 1, 0); PG8_STAGE(PG8_SA(0, 1), a2 + hstep, voffA);
            PG8_WAIT_V(8); PG8_WAIT_L(0); PG8_BAR; PG8_MMA(0, 0, At, B0); PG8_MMA(0, 1, At, B1); PG8_BAR; PG8_SCHED;
            PG8_LDA(At, 1, 1); PG8_STAGE(PG8_SB(1, 0), b3, voffB); PG8_STAGE(PG8_SB(1, 1), b3 + hstep, voffB); PG8_STAGE(PG8_SA(1, 0), a3, voffA);
            PG8_WAIT_V(8); PG8_WAIT_L(0); PG8_BAR; PG8_MMA(1, 0, At, B0); PG8_MMA(1, 1, At, B1); PG8_BAR; PG8_SCHED;
            if constexpr (Epi::KSCALE) { if (t == Epi::KS_T0 || t == Epi::KS_T1) { E.kscale(acc, lds, t == Epi::KS_T1 ? 1 : 0, wr, fr); PG8_SCHED; } }
            } else {
            PG8_LDB(B0, 0, 0); PG8_SCHED; PG8_LDA(At, 0, 0); PG8_STAGE(PG8_SA(1, 1), a1 + hstep, voffA);
            PG8_WAIT_L(8); PG8_BAR; PG8_WAIT_L(0); PG8_MMA(0, 0, At, B0); PG8_BAR; PG8_SCHED;
            PG8_LDB(B1, 0, 1); PG8_STAGE(PG8_SB(0, 0), b2, voffB);
            PG8_BAR; PG8_WAIT_L(0); PG8_MMA(0, 1, At, B1); PG8_BAR;
            PG8_LDA(At, 0, 1); PG8_STAGE(PG8_SA(0, 0), a2, voffA);
            PG8_BAR; PG8_WAIT_L(0); PG8_MMA(1, 0, At, B0); PG8_BAR; PG8_SCHED;
            PG8_STAGE(PG8_SB(0, 1), b2 + hstep, voffB);
            PG8_WAIT_V(6); PG8_BAR; PG8_MMA(1, 1, At, B1); PG8_BAR;
            PG8_LDB(B0, 1, 0); PG8_SCHED; PG8_LDA(At, 1, 0); PG8_STAGE(PG8_SA(0, 1), a2 + hstep, voffA);
            PG8_WAIT_L(8); PG8_BAR; PG8_WAIT_L(0); PG8_MMA(0, 0, At, B0); PG8_BAR; PG8_SCHED;
            PG8_LDB(B1, 1, 1); PG8_STAGE(PG8_SB(1, 0), b3, voffB);
            PG8_BAR; PG8_WAIT_L(0); PG8_MMA(0, 1, At, B1); PG8_BAR;
            PG8_LDA(At, 1, 1); PG8_STAGE(PG8_SA(1, 0), a3, voffA);
            PG8_BAR; PG8_WAIT_L(0); PG8_MMA(1, 0, At, B0); PG8_BAR; PG8_SCHED;
            PG8_STAGE(PG8_SB(1, 1), b3 + hstep, voffB);
            PG8_WAIT_V(6); PG8_BAR; PG8_MMA(1, 1, At, B1); PG8_BAR;
            }
        }
        if constexpr (ALIGN_EPI) { if (wr == 0) PG8_BAR; }
        if constexpr (!Epi::AFTER_DRAIN) { E(acc, cur, wr, wc, fr, fq); S.done(cur); }
        if (!has_next) break;
#pragma unroll
        for (int a = 0; a < 2; ++a)
#pragma unroll
            for (int b = 0; b < 2; ++b)
#pragma unroll
                for (int m = 0; m < 4; ++m)
#pragma unroll
                    for (int n = 0; n < 2; ++n) acc[a][b][m][n] = (f32x4){0.f, 0.f, 0.f, 0.f};
        cur = nxt; cA = nA; cB = nB; ++ui;
        if constexpr (ALIGN_EPI) { if (wr == 1) PG8_BAR; }
    }
    PG8_WAIT_V(0);
    if constexpr (!ALIGN_EPI) { if (wr == 0) PG8_BAR; }
    PG8_BAR;
    if constexpr (Epi::AFTER_DRAIN) { E.fused(acc, cur, wr, wc, fr, fq, lds, wid, lane); S.done(cur); }
#undef PG8_SA
#undef PG8_SB
#undef PG8_STAGE
#undef PG8_LDA
#undef PG8_LDB
#undef PG8_MMA
#undef PG8_WAIT_V
#undef PG8_WAIT_L
#undef PG8_BAR
#undef PG8_SCHED
}
}
#define LAS __attribute__((address_space(3)))
typedef unsigned short bf16;
typedef unsigned v4u __attribute__((ext_vector_type(4)));
typedef unsigned v2u __attribute__((ext_vector_type(2)));
typedef float f32x4 __attribute__((ext_vector_type(4)));
constexpr int D = 1024, BATCH = 16, SEQ = 2048, M = BATCH * SEQ;
constexpr int NHEADS = 16, HD = 64, NST = 128, CONVCH = 1536, MIXW = 1536, INW = 3088, NPROJ = 3072, FF = 4096, NMOD = 6 * D;
constexpr float EPS = 1e-5f;
constexpr int NWAVES = 8, NTHR = 512;
constexpr int LDS_BYTES = 147456;
constexpr size_t MiB = 1u << 20;
constexpr size_t WS_MOD = 0, WS_SHW = 1 * MiB, WS_ROWP = 480 * MiB, WS_DT = 2 * MiB, WS_SSQ = 4 * MiB, WS_WIN = 6 * MiB, WS_WOUT = 12 * MiB, WS_WUP = 16 * MiB, WS_WDN = 24 * MiB;
constexpr size_t WS_XN = 32 * MiB, WS_PROJ = 96 * MiB, WS_CONV = 288 * MiB, WS_YMIX = 384 * MiB, WS_F = 96 * MiB, WS_END = 482 * MiB;

__device__ __forceinline__ unsigned f2bf(float f) { unsigned u = __float_as_uint(f); return (u + 0x7fffu + ((u >> 16) & 1u)) >> 16; }
__device__ __forceinline__ unsigned pk2(float lo, float hi) { unsigned r; asm("v_cvt_pk_bf16_f32 %0, %1, %2" : "=v"(r) : "v"(lo), "v"(hi)); return r; }
__device__ __forceinline__ float bflo(unsigned w) { return __uint_as_float(w << 16); }
__device__ __forceinline__ float bfhi(unsigned w) { return __uint_as_float(w & 0xffff0000u); }
__device__ __forceinline__ void unpack8(const v4u w, float (&f)[8]) { f[0] = bflo(w.x); f[1] = bfhi(w.x); f[2] = bflo(w.y); f[3] = bfhi(w.y); f[4] = bflo(w.z); f[5] = bfhi(w.z); f[6] = bflo(w.w); f[7] = bfhi(w.w); }
__device__ __forceinline__ v4u pack8(const float (&f)[8]) { v4u w; w.x = pk2(f[0], f[1]); w.y = pk2(f[2], f[3]); w.z = pk2(f[4], f[5]); w.w = pk2(f[6], f[7]); return w; }
__device__ __forceinline__ float wave_sum(float v) {
#pragma unroll
    for (int o = 1; o < 64; o <<= 1) v += __shfl_xor(v, o);
    return v;
}
__device__ __forceinline__ float silu_f(float v) { return v * __builtin_amdgcn_rcpf(1.f + __builtin_amdgcn_exp2f(-1.44269504f * v)); }
__device__ __forceinline__ float softplus_f(float v) { return fmaxf(v, 0.f) + log1pf(__expf(-fabsf(v))); }

struct Args { const float* in[19]; float* out; unsigned char* ws; int ph_lo, ph_hi; };

__device__ __forceinline__ void transpose_item(const float* W, int ldw, int col0, int K, bf16* WT, int row_off, LAS float* scr, int kb, int nb, int lane, int src_row_off = 0, const float* kscale = nullptr) {
    const int k0 = 64 * kb, n0 = 32 * nb;
#pragma unroll 8
    for (int i = 0; i < 32; ++i) { const int kk = 2 * i + (lane >> 5); const float sc = kscale ? kscale[k0 + kk] : 1.0f; scr[kk * 33 + (lane & 31)] = sc * W[(size_t)(src_row_off + k0 + kk) * ldw + col0 + n0 + (lane & 31)]; }
    asm volatile("s_waitcnt lgkmcnt(0)" ::: "memory");
    const int c = lane & 7;
#pragma unroll
    for (int j = 0; j < 4; ++j) { const int n = (lane >> 3) + 8 * j; const LAS float* s = scr + (8 * c) * 33 + n;
        v4u o; o.x = pk2(s[0 * 33], s[1 * 33]); o.y = pk2(s[2 * 33], s[3 * 33]); o.z = pk2(s[4 * 33], s[5 * 33]); o.w = pk2(s[6 * 33], s[7 * 33]);
        *(v4u*)(WT + (size_t)(row_off + n0 + n) * K + k0 + 8 * c) = o; }
    asm volatile("s_waitcnt lgkmcnt(0)" ::: "memory");
}

template <bool SILU>
__device__ __forceinline__ void small_proj(LAS unsigned char* lds, const float* src, int sstride, const float* W, int ldw, int ncols, const float* bias, float* out, int ostride, int G) {
    const int tid = threadIdx.x, lane = tid & 63, wave = tid >> 6, nitems = ncols / 32;
    LAS float* cst = (LAS float*)lds;
    LAS float* part = (LAS float*)(lds + 65536);
    if ((int)blockIdx.x < nitems) {
        for (int i = tid; i < 16384; i += NTHR) { const int b = i >> 10, k = i & 1023; const float v = src[(size_t)b * sstride + k]; cst[k * 16 + b] = SILU ? silu_f(v) : v; }
        __syncthreads();
    }
    for (int it = blockIdx.x; it < nitems; it += G) {
        const int col0 = it * 32, kh = lane >> 5, col = lane & 31, kbase = wave * 128 + kh * 64;
        float acc[16];
#pragma unroll
        for (int b = 0; b < 16; ++b) acc[b] = 0.f;
#pragma unroll 8
        for (int i = 0; i < 64; ++i) {
            const int k = kbase + i; const float wv = W[(size_t)k * ldw + col0 + col];
#pragma unroll
            for (int q = 0; q < 4; ++q) { const f32x4 c4 = *(const LAS f32x4*)(cst + k * 16 + 4 * q); acc[4 * q + 0] += c4.x * wv; acc[4 * q + 1] += c4.y * wv; acc[4 * q + 2] += c4.z * wv; acc[4 * q + 3] += c4.w * wv; }
        }
#pragma unroll
        for (int b = 0; b < 16; ++b) part[((wave * 2 + kh) * 16 + b) * 32 + col] = acc[b];
        __syncthreads();
        { const int b = tid >> 5, cc = tid & 31; float sm = bias ? bias[col0 + cc] : 0.f;
#pragma unroll
          for (int p = 0; p < 16; ++p) sm += part[(p * 16 + b) * 32 + cc];
          out[(size_t)b * ostride + col0 + cc] = sm; }
        __syncthreads();
    }
    __syncthreads();
}

__device__ __forceinline__ void p0_prologue(LAS unsigned char* lds, const Args& a, int G) {
    const int tid = threadIdx.x, lane = tid & 63, wave = tid >> 6;
    unsigned char* ws = a.ws;
    const float* w_in = a.in[5];
    bf16* WtIn = (bf16*)(ws + WS_WIN);
    {
        LAS float* wp = (LAS float*)lds;
        LAS float* win = (LAS float*)(lds + 65536);
        for (int it = blockIdx.x; it < 256; it += G) {
            const int g = it >> 6, k0 = (it & 63) * 16;
            const float* wpg = a.in[12] + (size_t)g * 16384;
            for (int i = tid; i < 16384; i += NTHR) wp[i] = wpg[i];
            for (int i = tid; i < 2048; i += NTHR) { const int kk = i >> 7, c = i & 127; win[i] = w_in[(size_t)(k0 + kk) * INW + g * 128 + c]; }
            __syncthreads();
            const int kk = tid >> 5, d4 = (tid & 31) * 4;
            f32x4 acc = {0.f, 0.f, 0.f, 0.f};
#pragma unroll 8
            for (int c = 0; c < 128; ++c) { const float av = win[kk * 128 + c]; const f32x4 w4 = *(const LAS f32x4*)(wp + c * 128 + d4); acc += av * w4; }
#pragma unroll
            for (int e = 0; e < 4; ++e) WtIn[(size_t)(g * 128 + d4 + e) * D + k0 + kk] = (bf16)f2bf(acc[e]);
            __syncthreads();
        }
    }
    small_proj<true>(lds, a.in[1], D, a.in[2], NMOD, NMOD, a.in[3], (float*)(ws + WS_MOD), NMOD, G);
    __syncthreads();
    {
        LAS float* scr = (LAS float*)(lds + wave * 16384);
        const int gw = blockIdx.x * NWAVES + wave, NGW = G * NWAVES;
        constexpr int I_IN = 16 * 80, I_OUT = 24 * 32, I_UP = 16 * 128, I_DN = 64 * 32;
        for (int it = gw; it < I_IN + I_OUT + I_UP + I_DN; it += NGW) {
            int r = it;
            if (r < I_IN) { transpose_item(w_in, INW, 512, D, WtIn, 512, scr, r / 80, r % 80, lane); continue; } r -= I_IN;
            if (r < I_OUT) { const int kb = r / 32;
                transpose_item(a.in[14], D, 0, MIXW, (bf16*)(ws + WS_WOUT), 0, scr, kb, r % 32, lane, kb < 16 ? 512 : -1024, kb < 16 ? a.in[11] : nullptr); continue; } r -= I_OUT;
            if (r < I_UP) { transpose_item(a.in[16], FF, 0, D, (bf16*)(ws + WS_WUP), 0, scr, r / 128, r % 128, lane); continue; } r -= I_UP;
            transpose_item(a.in[17], D, 0, FF, (bf16*)(ws + WS_WDN), 0, scr, r / 32, r % 32, lane);
        }
    }
}

template <bool WITH_DT>
__device__ __forceinline__ void normmod_phase(LAS unsigned char* lds, const float* src, const float* gvec, const float* MOD, int shift_ofs, int scale_ofs, bf16* XN,
                                              const float* w_in, const float* dt_bias, float* DT, int G) {
    const int tid = threadIdx.x, lane = tid & 63, wave = tid >> 6;
    LAS float* WdtL = (LAS float*)lds;
    if (WITH_DT) {
        for (int i = tid; i < 16384; i += NTHR) { const int k = i >> 4, h = i & 15; WdtL[h * 1024 + k] = w_in[(size_t)k * INW + NPROJ + h]; }
        __syncthreads();
    }
    const int gw = blockIdx.x * NWAVES + wave, NGW = G * NWAVES;
    for (int rg = gw; rg < M / 16; rg += NGW) {
        const int m0 = rg * 16, b = m0 / SEQ;
        const float* mp = MOD + (size_t)b * NMOD;
        f32x4 gs[4], sh[4];
#pragma unroll
        for (int j = 0; j < 4; ++j) { const int k = 4 * lane + 256 * j; const f32x4 g4 = *(const f32x4*)(gvec + k); const f32x4 sc = *(const f32x4*)(mp + scale_ofs + k); gs[j] = g4 * (sc + 1.0f); sh[j] = *(const f32x4*)(mp + shift_ofs + k); }
        for (int r = 0; r < 16; ++r) {
            const int m = m0 + r;
            const f32x4* xr = (const f32x4*)(src + (size_t)m * D) + lane;
            f32x4 v[4]; float ss = 0.f;
#pragma unroll
            for (int j = 0; j < 4; ++j) { v[j] = xr[64 * j]; ss += (v[j].x * v[j].x + v[j].y * v[j].y) + (v[j].z * v[j].z + v[j].w * v[j].w); }
            ss = wave_sum(ss);
            const float rinv = 1.0f / sqrtf(ss * (1.0f / D) + EPS);
#pragma unroll
            for (int j = 0; j < 4; ++j) v[j] = v[j] * rinv * gs[j] + sh[j];
            unsigned long long* o8 = (unsigned long long*)(XN + (size_t)m * D) + lane;
#pragma unroll
            for (int j = 0; j < 4; ++j) o8[64 * j] = (unsigned long long)pk2(v[j].x, v[j].y) | ((unsigned long long)pk2(v[j].z, v[j].w) << 32);
            if (WITH_DT) {
                float acc[16];
#pragma unroll
                for (int h = 0; h < 16; ++h) { float s = 0.f;
#pragma unroll
                    for (int j = 0; j < 4; ++j) { const f32x4 w4 = *(const LAS f32x4*)(WdtL + h * 1024 + 4 * lane + 256 * j); s += (v[j].x * w4.x + v[j].y * w4.y) + (v[j].z * w4.z + v[j].w * w4.w); }
                    acc[h] = s; if ((h & 3) == 3) asm volatile("" ::: "memory"); }
                float a8[8], a4[4], a2[2], a1;
                const bool u5 = (lane & 32) != 0, u4 = (lane & 16) != 0, u3 = (lane & 8) != 0, u2 = (lane & 4) != 0;
#pragma unroll
                for (int i = 0; i < 8; ++i) { const float keep = u5 ? acc[i + 8] : acc[i], send = u5 ? acc[i] : acc[i + 8]; a8[i] = keep + __shfl_xor(send, 32); }
#pragma unroll
                for (int i = 0; i < 4; ++i) { const float keep = u4 ? a8[i + 4] : a8[i], send = u4 ? a8[i] : a8[i + 4]; a4[i] = keep + __shfl_xor(send, 16); }
#pragma unroll
                for (int i = 0; i < 2; ++i) { const float keep = u3 ? a4[i + 2] : a4[i], send = u3 ? a4[i] : a4[i + 2]; a2[i] = keep + __shfl_xor(send, 8); }
                { const float keep = u2 ? a2[1] : a2[0], send = u2 ? a2[0] : a2[1]; a1 = keep + __shfl_xor(send, 4); }
                a1 += __shfl_xor(a1, 2); a1 += __shfl_xor(a1, 1);
                const int h = ((lane >> 5) & 1) * 8 + ((lane >> 4) & 1) * 4 + ((lane >> 3) & 1) * 2 + ((lane >> 2) & 1);
                if ((lane & 3) == 0) DT[(size_t)m * 16 + h] = softplus_f(a1 + dt_bias[h]);
            }
        }
    }
}

template <int TAPS, bool POOL>
__device__ __forceinline__ void fir_rows(const Args& a, int G, int cgi, int rsub) {
    const bf16* PROJ = (const bf16*)(a.ws + WS_PROJ);
    const int c0 = cgi * 8;
    const bf16* src = PROJ + (POOL ? 0 : 1536) + c0;
    bf16* dst = POOL ? (bf16*)(a.ws + WS_YMIX) + 1024 + c0 : (bf16*)(a.ws + WS_CONV) + c0;
    const int dstride = POOL ? MIXW : CONVCH;
    const int w = POOL ? (2 << (c0 >> 7)) : 4;
    float pa[8], pb[4][8];
#pragma unroll
    for (int e = 0; e < 8; ++e) { pa[e] = POOL ? a.in[13][c0 + e] : a.in[7][c0 + e];
#pragma unroll
        for (int k = 0; k < 4; ++k) pb[k][e] = POOL ? 0.f : a.in[6][k * CONVCH + c0 + e]; }
    for (int blk = blockIdx.x; blk < M / 128; blk += G)
        for (int i = 0; i < 16; ++i) {
            const int m0 = blk * 128 + (i * 2 + rsub) * 4, s0 = m0 & (SEQ - 1);
            v4u L[TAPS + 3];
#pragma unroll
            for (int r = 0; r < TAPS + 3; ++r) { const int rel = r - (TAPS - 1);
                if (s0 + rel >= 0) L[r] = *(const v4u*)(src + (size_t)(m0 + rel) * NPROJ); else L[r] = (v4u){0u, 0u, 0u, 0u}; }
#pragma unroll
            for (int o = 0; o < 4; ++o) {
                float acc[8];
                if (POOL) {
                    const int nv = min(s0 + o + 1, w); const float inv = 1.0f / (float)nv;
#pragma unroll
                    for (int e = 0; e < 8; ++e) acc[e] = 0.f;
#pragma unroll
                    for (int j = 0; j < TAPS; ++j) { float t[8]; unpack8(L[TAPS - 1 + o - j], t); const float cj = (j < nv) ? 1.0f : 0.0f;
#pragma unroll
                        for (int e = 0; e < 8; ++e) acc[e] += cj * t[e]; }
                    float cur[8]; unpack8(L[TAPS - 1 + o], cur);
#pragma unroll
                    for (int e = 0; e < 8; ++e) acc[e] = (acc[e] * inv - cur[e]) * pa[e];
                } else {
#pragma unroll
                    for (int e = 0; e < 8; ++e) acc[e] = pa[e];
#pragma unroll
                    for (int k = 0; k < 4; ++k) { float t[8]; unpack8(L[o + k], t);
#pragma unroll
                        for (int e = 0; e < 8; ++e) acc[e] += pb[k][e] * t[e]; }
#pragma unroll
                    for (int e = 0; e < 8; ++e) acc[e] = silu_f(acc[e]);
                }
                *(v4u*)(dst + (size_t)(m0 + o) * dstride) = pack8(acc);
            }
        }
}
__device__ __forceinline__ void halo_phase(const Args& a, int G) {
    const int tid = threadIdx.x, cgp = tid & 255, rsub = tid >> 8;
    if (cgp < 64) fir_rows<16, true>(a, G, cgp, rsub); else fir_rows<4, false>(a, G, cgp - 64, rsub);
}

__device__ __forceinline__ void ssd_naive_phase(LAS unsigned char* lds, const Args& a, int G) {
    const int tid = threadIdx.x;
    LAS float* xs = (LAS float*)lds;
    LAS float* Bs = (LAS float*)(lds + 16384);
    LAS float* Cs = (LAS float*)(lds + 49152);
    LAS float* yb = (LAS float*)(lds + 81920);
    LAS float* dts = (LAS float*)(lds + 98304);
    LAS float* dAs = (LAS float*)(lds + 98304 + 256);
    const bf16* PROJ = (const bf16*)(a.ws + WS_PROJ); const bf16* CONV = (const bf16*)(a.ws + WS_CONV);
    bf16* YMIX = (bf16*)(a.ws + WS_YMIX); const float* DT = (const float*)(a.ws + WS_DT); float* SSQ = (float*)(a.ws + WS_SSQ);
    const int p = tid >> 3, nq = tid & 7, n0 = nq * 16;
    for (int it = blockIdx.x; it < BATCH * NHEADS; it += G) {
        const int b = it >> 4, hh = it & 15, g = hh >> 3;
        const float av = -__expf(a.in[9][hh]), dsk = a.in[10][hh];
        float h[16];
#pragma unroll
        for (int i = 0; i < 16; ++i) h[i] = 0.f;
        for (int ck = 0; ck < SEQ / 64; ++ck) {
            const size_t m0 = (size_t)b * SEQ + ck * 64;
            { const int t = tid >> 3, part = tid & 7; float f[8]; unpack8(*(const v4u*)(CONV + (m0 + t) * CONVCH + hh * 64 + part * 8), f);
#pragma unroll
              for (int e = 0; e < 8; ++e) xs[t * 64 + part * 8 + e] = f[e]; }
#pragma unroll
            for (int i = 0; i < 2; ++i) { const int piece = tid + i * NTHR, t = piece >> 4, part = piece & 15; float f[8];
                unpack8(*(const v4u*)(CONV + (m0 + t) * CONVCH + 1024 + g * 128 + part * 8), f);
#pragma unroll
                for (int e = 0; e < 8; ++e) Bs[t * 128 + part * 8 + e] = f[e];
                unpack8(*(const v4u*)(CONV + (m0 + t) * CONVCH + 1280 + g * 128 + part * 8), f);
#pragma unroll
                for (int e = 0; e < 8; ++e) Cs[t * 128 + part * 8 + e] = f[e]; }
            if (tid < 64) { const float dtv = DT[(m0 + tid) * 16 + hh]; dts[tid] = dtv; dAs[tid] = __expf(dtv * av); }
            __syncthreads();
            for (int t = 0; t < 64; ++t) {
                const float xr = xs[t * 64 + p], xv = xr * dts[t], dA = dAs[t];
                float yp = 0.f;
#pragma unroll
                for (int q = 0; q < 4; ++q) { const f32x4 b4 = *(const LAS f32x4*)(Bs + t * 128 + n0 + 4 * q), c4 = *(const LAS f32x4*)(Cs + t * 128 + n0 + 4 * q);
#pragma unroll
                    for (int e = 0; e < 4; ++e) { h[4 * q + e] = h[4 * q + e] * dA + xv * b4[e]; yp += h[4 * q + e] * c4[e]; } }
                yp += __shfl_xor(yp, 1); yp += __shfl_xor(yp, 2); yp += __shfl_xor(yp, 4);
                if (nq == 0) yb[t * 64 + p] = yp + dsk * xr;
            }
            __syncthreads();
            { const int t = tid >> 3, part = tid & 7; float z[8], y[8]; unpack8(*(const v4u*)(PROJ + (m0 + t) * NPROJ + 512 + hh * 64 + part * 8), z);
              float sq = 0.f;
#pragma unroll
              for (int e = 0; e < 8; ++e) { y[e] = yb[t * 64 + part * 8 + e] * silu_f(z[e]); sq += y[e] * y[e]; }
              sq += __shfl_xor(sq, 1); sq += __shfl_xor(sq, 2); sq += __shfl_xor(sq, 4);
              if (part == 0) SSQ[(m0 + t) * 16 + hh] = sq;
              *(v4u*)(YMIX + (m0 + t) * MIXW + 512 + hh * 64 + part * 8) = pack8(y); }
            __syncthreads();
        }
    }
}

typedef short s16x4 __attribute__((ext_vector_type(4)));
typedef short bf16x8 __attribute__((ext_vector_type(8)));
__device__ __forceinline__ bf16x8 frag_row(LAS unsigned char* base, int stride, int row0, int k0, int x, int y) { return *(const LAS bf16x8*)(base + (row0 + x) * stride + (k0 + 8 * y) * 2); }
__device__ __forceinline__ bf16x8 frag_tr(LAS unsigned char* base, int stride, int krow0, int col0, int lane) {
    const int y = lane >> 4, q = (lane >> 2) & 3, p = lane & 3;
    LAS unsigned char* a0 = base + (krow0 + 4 * y + q) * stride + (col0 + 4 * p) * 2;
    const s16x4 r0 = __builtin_amdgcn_ds_read_tr16_b64_v4i16((LAS s16x4*)a0);
    const s16x4 r1 = __builtin_amdgcn_ds_read_tr16_b64_v4i16((LAS s16x4*)(a0 + 16 * stride));
    return __builtin_shufflevector(r0, r1, 0, 1, 2, 3, 4, 5, 6, 7);
}
__device__ __forceinline__ void ssd_chunk_phase(LAS unsigned char* lds, const Args& a, int G) {
    const int tid = threadIdx.x, lane = tid & 63, w = __builtin_amdgcn_readfirstlane(tid >> 6), x = lane & 15, y = lane >> 4;
    constexpr int CS = 0, CSS = 272, BS = 34816, BSS = 288, XS = 71680, XSS = 160, XW = 92160, HB = 112640, HBS = 272, TAB = 130048;
    LAS float* t_acum = (LAS float*)(lds + TAB); LAS float* t_dt = t_acum + 128; LAS float* t_ea = t_acum + 256; LAS float* t_wl = t_acum + 384; LAS float* t_misc = t_acum + 512;
    const bf16* PROJ = (const bf16*)(a.ws + WS_PROJ); const bf16* CONV = (const bf16*)(a.ws + WS_CONV);
    bf16* YMIX = (bf16*)(a.ws + WS_YMIX); const float* DT = (const float*)(a.ws + WS_DT); float* SSQ = (float*)(a.ws + WS_SSQ);
    for (int it0 = blockIdx.x; it0 < BATCH * NHEADS; it0 += G) {
        const int xcd = it0 & 7, slot = it0 >> 3, qq = xcd * 4 + (slot >> 3), b = qq >> 1, g = qq & 1, hh = g * 8 + (slot & 7);
        const float av = -__expf(a.in[9][hh]), dsk = a.in[10][hh];
        f32x4 hst[4];
#pragma unroll
        for (int nt = 0; nt < 4; ++nt) hst[nt] = (f32x4){0.f, 0.f, 0.f, 0.f};
        v4u rc[4], rb[4], rx[2]; float d0 = 0.f, d1 = 0.f;
        const bf16* cbase = CONV + (size_t)b * SEQ * CONVCH;
#define SSD_LOAD(ck_) do { const bf16* cb_ = cbase + (size_t)(ck_) * 128 * CONVCH; \
            _Pragma("unroll") for (int i = 0; i < 4; ++i) { const int piece = tid + i * NTHR, row = piece >> 4, part = piece & 15; \
                rc[i] = *(const v4u*)(cb_ + (size_t)row * CONVCH + 1280 + g * 128 + part * 8); rb[i] = *(const v4u*)(cb_ + (size_t)row * CONVCH + 1024 + g * 128 + part * 8); } \
            _Pragma("unroll") for (int i = 0; i < 2; ++i) { const int piece = tid + i * NTHR, row = piece >> 3, part = piece & 7; rx[i] = *(const v4u*)(cb_ + (size_t)row * CONVCH + hh * 64 + part * 8); } \
            if (w == 0) { const size_t mm_ = (size_t)b * SEQ + (ck_) * 128 + 2 * lane; d0 = DT[mm_ * 16 + hh]; d1 = DT[(mm_ + 1) * 16 + hh]; } } while (0)
        SSD_LOAD(0);
        for (int ck = 0; ck < SEQ / 128; ++ck) {
            const size_t m0 = (size_t)b * SEQ + ck * 128;
            const int lt = (w < 4) ? w : 11 - w;
            const int l = 16 * lt + x;
            v2u rz[4];
#pragma unroll
            for (int pt = 0; pt < 4; ++pt) rz[pt] = *(const v2u*)(PROJ + (m0 + l) * NPROJ + 512 + hh * 64 + 16 * pt + 4 * y);
            if (w == 0) {
                const float a0 = d0 * av, a1 = d1 * av; float sc = a0 + a1;
#pragma unroll
                for (int o = 1; o < 64; o <<= 1) { const float t = __shfl_up(sc, o); if (lane >= o) sc += t; }
                const float c1 = sc, c0 = sc - a1, alast = __shfl(sc, 63);
                t_acum[2 * lane] = c0; t_acum[2 * lane + 1] = c1; t_dt[2 * lane] = d0; t_dt[2 * lane + 1] = d1;
                t_ea[2 * lane] = __expf(c0); t_ea[2 * lane + 1] = __expf(c1);
                t_wl[2 * lane] = d0 * __expf(alast - c0); t_wl[2 * lane + 1] = d1 * __expf(alast - c1);
                if (lane == 0) t_misc[0] = __expf(alast);
            }
#pragma unroll
            for (int i = 0; i < 4; ++i) { const int piece = tid + i * NTHR, row = piece >> 4, part = piece & 15;
                *(LAS v4u*)(lds + CS + row * CSS + part * 16) = rc[i]; *(LAS v4u*)(lds + BS + row * BSS + part * 16) = rb[i]; }
#pragma unroll
            for (int i = 0; i < 2; ++i) { const int piece = tid + i * NTHR, row = piece >> 3, part = piece & 7; *(LAS v4u*)(lds + XS + row * XSS + part * 16) = rx[i]; }
#pragma unroll
            for (int nt = 0; nt < 4; ++nt) { const int p = 16 * (w & 3) + x, n = 16 * (4 * (w >> 2) + nt) + 4 * y;
                *(LAS v2u*)(lds + HB + p * HBS + n * 2) = (v2u){pk2(hst[nt].x, hst[nt].y), pk2(hst[nt].z, hst[nt].w)}; }
            __syncthreads();
#pragma unroll
            for (int i = 0; i < 2; ++i) { const int piece = tid + i * NTHR, row = piece >> 3, part = piece & 7; const float wl = t_wl[row]; float f[8]; unpack8(rx[i], f);
#pragma unroll
                for (int e = 0; e < 8; ++e) f[e] *= wl;
                *(LAS v4u*)(lds + XW + row * XSS + part * 16) = pack8(f); }
            __syncthreads();
            if (ck + 1 < SEQ / 128) SSD_LOAD(ck + 1);
            bf16x8 cf[4];
#pragma unroll
            for (int ks = 0; ks < 4; ++ks) cf[ks] = frag_row(lds + CS, CSS, 16 * lt, 32 * ks, x, y);
            f32x4 sacc[8];
#pragma unroll
            for (int ts = 0; ts < 8; ++ts) { sacc[ts] = (f32x4){0.f, 0.f, 0.f, 0.f};
                if (ts <= lt) {
#pragma unroll
                for (int ks = 0; ks < 4; ++ks) sacc[ts] = __builtin_amdgcn_mfma_f32_16x16x32_bf16(frag_row(lds + BS, BSS, 16 * ts, 32 * ks, x, y), cf[ks], sacc[ts], 0, 0, 0); } }
            f32x4 yacc[4];
            const float ea_l = t_ea[l], ac_l = t_acum[l];
#pragma unroll
            for (int pt = 0; pt < 4; ++pt) { yacc[pt] = (f32x4){0.f, 0.f, 0.f, 0.f};
#pragma unroll
                for (int ks = 0; ks < 4; ++ks) yacc[pt] = __builtin_amdgcn_mfma_f32_16x16x32_bf16(frag_row(lds + HB, HBS, 16 * pt, 32 * ks, x, y), cf[ks], yacc[pt], 0, 0, 0);
                yacc[pt] = yacc[pt] * ea_l; }
#pragma unroll
            for (int ts = 0; ts < 8; ++ts) if (ts <= (lt | 1)) { const f32x4 as = *(const LAS f32x4*)(t_acum + 16 * ts + 4 * y), ds = *(const LAS f32x4*)(t_dt + 16 * ts + 4 * y); float gv[4];
#pragma unroll
                for (int e = 0; e < 4; ++e) { const int s = 16 * ts + 4 * y + e; const float ev = (s <= l) ? __expf(ac_l - as[e]) : 0.f; gv[e] = sacc[ts][e] * ev * ds[e]; }
                const int c = 32 * (ts >> 1) + 8 * y + 4 * (ts & 1);
                *(LAS v2u*)(lds + CS + l * CSS + c * 2) = (v2u){pk2(gv[0], gv[1]), pk2(gv[2], gv[3])}; }
            { const float cd = t_misc[0];
#pragma unroll
              for (int nt = 0; nt < 4; ++nt) hst[nt] = hst[nt] * cd;
#pragma unroll
              for (int ks = 0; ks < 4; ++ks) { const bf16x8 xf = frag_tr(lds + XW, XSS, 32 * ks, 16 * (w & 3), lane);
#pragma unroll
                  for (int nt = 0; nt < 4; ++nt) hst[nt] = __builtin_amdgcn_mfma_f32_16x16x32_bf16(frag_tr(lds + BS, BSS, 32 * ks, 16 * (4 * (w >> 2) + nt), lane), xf, hst[nt], 0, 0, 0); } }
#pragma unroll
            for (int ks = 0; ks < 4; ++ks) if (ks <= (lt >> 1)) { const bf16x8 gf = frag_row(lds + CS, CSS, 16 * lt, 32 * ks, x, y);
#pragma unroll
                for (int pt = 0; pt < 4; ++pt) yacc[pt] = __builtin_amdgcn_mfma_f32_16x16x32_bf16(frag_tr(lds + XS, XSS, 32 * ks, 16 * pt, lane), gf, yacc[pt], 0, 0, 0); }
            { const size_t m = m0 + l; float sq = 0.f;
#pragma unroll
              for (int pt = 0; pt < 4; ++pt) { const v2u xr = *(const LAS v2u*)(lds + XS + l * XSS + (16 * pt + 4 * y) * 2);
                  const float y0 = (yacc[pt].x + dsk * bflo(xr.x)) * silu_f(bflo(rz[pt].x)), y1 = (yacc[pt].y + dsk * bfhi(xr.x)) * silu_f(bfhi(rz[pt].x));
                  const float y2 = (yacc[pt].z + dsk * bflo(xr.y)) * silu_f(bflo(rz[pt].y)), y3 = (yacc[pt].w + dsk * bfhi(xr.y)) * silu_f(bfhi(rz[pt].y));
                  sq += (y0 * y0 + y1 * y1) + (y2 * y2 + y3 * y3);
                  *(v2u*)(YMIX + m * MIXW + hh * 64 + 16 * pt + 4 * y) = (v2u){pk2(y0, y1), pk2(y2, y3)}; }
              sq += __shfl_xor(sq, 16); sq += __shfl_xor(sq, 32);
              if (y == 0) SSQ[m * 16 + hh] = sq; }
            __syncthreads();
        }
#undef SSD_LOAD
    }
}

__device__ __forceinline__ void ssdnorm_phase(const Args& a, int G) {
    const int tid = threadIdx.x, rsub = tid >> 7, c8 = (tid & 127) * 8, g = c8 >> 9;
    bf16* YMIX = (bf16*)(a.ws + WS_YMIX); const float* SSQ = (const float*)(a.ws + WS_SSQ);
    float gsd[8];
#pragma unroll
    for (int e = 0; e < 8; ++e) gsd[e] = a.in[11][c8 + e];
    for (int r4 = blockIdx.x; r4 < M / 4; r4 += G) {
        const size_t m = (size_t)r4 * 4 + rsub;
        const f32x4 s0 = *(const f32x4*)(SSQ + m * 16 + g * 8), s1 = *(const f32x4*)(SSQ + m * 16 + g * 8 + 4);
        const float ss = ((s0.x + s0.y) + (s0.z + s0.w)) + ((s1.x + s1.y) + (s1.z + s1.w));
        const float rinv = 1.0f / sqrtf(ss * (1.0f / 512.0f) + EPS);
        float y[8]; v4u* pp = (v4u*)(YMIX + m * MIXW + 512 + c8); unpack8(*pp, y);
#pragma unroll
        for (int e = 0; e < 8; ++e) y[e] = y[e] * rinv * gsd[e];
        *pp = pack8(y);
    }
}

__device__ __forceinline__ void finalnorm_phase(const Args& a, int G) {
    const int tid = threadIdx.x, lane = tid & 63, wave = tid >> 6;
    const int gw = blockIdx.x * NWAVES + wave, NGW = G * NWAVES;
    f32x4 gf[4];
#pragma unroll
    for (int j = 0; j < 4; ++j) gf[j] = *(const f32x4*)(a.in[18] + 4 * lane + 256 * j);
    for (int m = gw; m < M; m += NGW) {
        f32x4* xr = (f32x4*)(a.out + (size_t)m * D) + lane;
        f32x4 v[4]; float ss = 0.f;
#pragma unroll
        for (int j = 0; j < 4; ++j) { v[j] = xr[64 * j]; ss += (v[j].x * v[j].x + v[j].y * v[j].y) + (v[j].z * v[j].z + v[j].w * v[j].w); }
        ss = wave_sum(ss);
        const float rinv = 1.0f / sqrtf(ss * (1.0f / D) + EPS);
#pragma unroll
        for (int j = 0; j < 4; ++j) xr[64 * j] = v[j] * rinv * gf[j];
    }
}

constexpr int NPHASES = 11;
__global__ void __launch_bounds__(NTHR, 2) fwd_kernel(Args args) {
    extern __shared__ __attribute__((aligned(16))) unsigned char lds_raw[];
    LAS unsigned char* lds = (LAS unsigned char*)lds_raw;
    cg::grid_group grid = cg::this_grid();
    const int G = gridDim.x, lo = args.ph_lo, hi = args.ph_hi;
    unsigned char* ws = args.ws;
    float* MOD = (float*)(ws + WS_MOD);
#ifndef PH_MASK
#define PH_MASK 0x7ff
#endif
#define IN(k) ((((PH_MASK) >> (k)) & 1) && lo <= (k) && (k) < hi)
#ifndef PROBE_DUP
#define PROBE_DUP -1
#endif
#define PH(k, ...) do { if (IN(k)) { __VA_ARGS__ if (PROBE_DUP == (k)) { grid.sync(); __VA_ARGS__ } } } while (0);
#define SEAM67() do { if (IN(6) && IN(8)) grid.sync(); } while (0)
#define SEAMX(a_, b_) do { if (IN(a_) && IN(b_)) grid.sync(); } while (0)
#define SEAM(k) do { if (IN(k) && IN((k) + 1)) grid.sync(); } while (0)
    PH(0, { p0_prologue(lds, args, G); }) SEAM(0);
    PH(1, { small_proj<false>(lds, MOD + 3072, NMOD, args.in[16], FF, FF, nullptr, (float*)(ws + WS_SHW), FF, G); normmod_phase<true>(lds, args.in[0], args.in[4], MOD, 0, 1024, (bf16*)(ws + WS_XN), args.in[5], args.in[8], (float*)(ws + WS_DT), G); __syncthreads(); }) SEAM(1);
    PH(2, { pg8::Gemm g{(const bf16*)(ws + WS_XN), (const bf16*)(ws + WS_WIN), M, NPROJ, D}; pg8::StaticOrder S; S.init(M, NPROJ, G, (int)blockIdx.x);
        pg8::EpiBf16<0> E{(bf16*)(ws + WS_PROJ), NPROJ}; pg8::gemm_phase<pg8::EpiBf16<0>, pg8::StaticOrder, true, true>(lds, g, S, E); }) SEAM(2);
    PH(3, { halo_phase(args, G); }) SEAM(3);
    #ifdef SSD_NAIVE
    PH(4, { ssd_naive_phase(lds, args, G); }) SEAMX(4, 6);
#else
    PH(4, { ssd_chunk_phase(lds, args, G); }) SEAMX(4, 6);
#endif
    PH(6, { pg8::Gemm g{(const bf16*)(ws + WS_YMIX), (const bf16*)(ws + WS_WOUT), M, D, MIXW}; pg8::SsdOrder S; S.init(M, D, G, (int)blockIdx.x); S.ssq = (const float*)(ws + WS_SSQ); S.lds = lds; S.eps = EPS;
        pg8::EpiResGate2 E{args.in[0], args.out, MOD + 2048, args.in[15], MOD + 4096, (bf16*)(ws + WS_XN), (float*)(ws + WS_ROWP), SEQ, NMOD}; pg8::gemm_phase<pg8::EpiResGate2, pg8::SsdOrder, true, true>(lds, g, S, E); }) SEAM67();
    PH(8, { pg8::Gemm g{(const bf16*)(ws + WS_XN), (const bf16*)(ws + WS_WUP), M, FF, D}; pg8::StaticOrder S; S.init(M, FF, G, (int)blockIdx.x);
        pg8::EpiUp E{(bf16*)(ws + WS_F), FF, (const float*)(ws + WS_ROWP), (const float*)(ws + WS_SHW), SEQ, 1.0f / D, EPS}; pg8::gemm_phase<pg8::EpiUp, pg8::StaticOrder, true, true>(lds, g, S, E); }) SEAM(8);
    PH(9, { pg8::Gemm g{(const bf16*)(ws + WS_F), (const bf16*)(ws + WS_WDN), M, D, FF}; pg8::StaticOrder S; S.init(M, D, G, (int)blockIdx.x);
        pg8::EpiResGate E{args.out, args.out, MOD + 5120, SEQ, NMOD}; pg8::gemm_phase<pg8::EpiResGate, pg8::StaticOrder, true, true>(lds, g, S, E); }) SEAM(9);
    PH(10, { finalnorm_phase(args, G); })
#undef IN
#undef SEAM
}

#ifndef MK_ONE_LAUNCH
#define MK_ONE_LAUNCH 1
#endif
extern "C" void kernel_launch(void* const* d_in, const int* in_sizes, int n_in, void* d_out, int out_size, void* d_ws, size_t ws_size, hipStream_t stream) {
    static int grid = 0;
    if (grid == 0) {
        if (n_in != 19 || out_size != M * D || ws_size < WS_END) { fprintf(stderr, "kernel_launch: unexpected shapes (n_in %d, out %d, ws %zu)\n", n_in, out_size, ws_size); grid = -1; return; }
        int dev = 0, cus = 0, per_cu = 0;
        if (hipGetDevice(&dev) != hipSuccess || hipDeviceGetAttribute(&cus, hipDeviceAttributeMultiprocessorCount, dev) != hipSuccess) { grid = -1; return; }
        if (hipFuncSetAttribute((const void*)fwd_kernel, hipFuncAttributeMaxDynamicSharedMemorySize, LDS_BYTES) != hipSuccess) { fprintf(stderr, "kernel_launch: hipFuncSetAttribute failed\n"); grid = -1; return; }
        if (hipOccupancyMaxActiveBlocksPerMultiprocessor(&per_cu, (const void*)fwd_kernel, NTHR, LDS_BYTES) != hipSuccess || per_cu < 1) { fprintf(stderr, "kernel_launch: occupancy query says %d\n", per_cu); (void)hipGetLastError(); per_cu = 1; }
        grid = cus * per_cu;
        fprintf(stderr, "kernel_launch: grid %d (cus %d x %d)\n", grid, cus, per_cu);
    }
    if (grid < 0) return;
    Args a{};
    for (int i = 0; i < 19; ++i) a.in[i] = (const float*)d_in[i];
    a.out = (float*)d_out; a.ws = (unsigned char*)d_ws;
#if MK_ONE_LAUNCH
    a.ph_lo = 0; a.ph_hi = NPHASES;
    void* kargs[] = {&a};
    hipError_t e = hipLaunchCooperativeKernel((const void*)fwd_kernel, dim3(grid), dim3(NTHR), kargs, LDS_BYTES, stream);
    if (e != hipSuccess) fprintf(stderr, "kernel_launch: cooperative launch failed: %s (grid %d)\n", hipGetErrorString(e), grid);
#else
    for (int ph = 0; ph < NPHASES; ++ph) {
        a.ph_lo = ph; a.ph_hi = ph + 1;
        hipLaunchKernelGGL(fwd_kernel, dim3(grid), dim3(NTHR), LDS_BYTES, stream, a);
    }
#endif
}
```

```cpp
#include <hip/hip_runtime.h>
#include <hip/hip_cooperative_groups.h>
#include <cstdio>
#include <cstdint>
namespace cg = cooperative_groups;
namespace pg8 {
#define PG8_LAS __attribute__((address_space(3)))
typedef unsigned short bf16_t;
typedef short bf16x8 __attribute__((ext_vector_type(8)));
typedef float f32x4 __attribute__((ext_vector_type(4)));
typedef unsigned u32x4 __attribute__((ext_vector_type(4)));
constexpr int BM = 256, BK = 64, HALF = 128, HTB = HALF * BK * 2  , STAGE_BYTES = 8 * HTB, NXCD = 8, WGM = 8;

__host__ __device__ __forceinline__ int lds_byte(int r, int c) { const int st = (r >> 4) * 2 + (c >> 5), rr = r & 15, cc = c & 31, ob = rr * 64 + cc * 2; return st * 1024 + (ob ^ (((ob >> 9) & 1) << 5)); }
__host__ __device__ __forceinline__ void stage_rc(int b, int& R, int& C) { const int st = b / 1024, sb = b % 1024, swz = sb ^ (((sb >> 9) & 1) << 5); R = (st >> 1) * 16 + swz / 64; C = (st & 1) * 32 + (swz % 64) / 2; }
__host__ __device__ __forceinline__ int perm32(int rho) { const int n = rho >> 4, i = rho & 15; return 8 * (i >> 2) + 4 * n + (i & 3); }

struct Unit { int pm, pn; };
struct Gemm { const bf16_t* A; const bf16_t* Bt; int M, N, K; };

struct StaticOrder {
    int nM, nN, nwg, G, c;
    __host__ __device__ void init(int M, int N, int G_, int c_) { nM = M / BM; nN = N / BM; nwg = nM * nN; G = G_; c = c_; }
    __host__ __device__ bool next(int i, Unit& u) const {
        const long L = (long)i * G + c; if (L >= nwg) return false;
        int wgid = (int)L; { const int q = nwg / NXCD, r = nwg % NXCD, xcd = wgid % NXCD, off = wgid / NXCD; wgid = (xcd < r ? xcd * (q + 1) : r * (q + 1) + (xcd - r) * q) + off; }
        const int nig = WGM * nN, gid = wgid / nig, fm = gid * WGM, gsz = (nM - fm) < WGM ? (nM - fm) : WGM;
        u.pm = fm + ((wgid % nig) % gsz); u.pn = (wgid % nig) / gsz; return true;
    }
    __device__ __forceinline__ void a_ready(const Unit&) const {}
    __device__ __forceinline__ void done(const Unit&) const {}
};

struct SsdOrder : StaticOrder {
    const float* ssq; PG8_LAS unsigned char* lds; float eps;
    __device__ __forceinline__ void a_ready(const Unit& u) const {
        const int tid = threadIdx.x;
        if (tid < 256) { const f32x4* sp = (const f32x4*)(ssq + (size_t)(u.pm * BM + tid) * 16); const f32x4 a0 = sp[0], a1 = sp[1], b0 = sp[2], b1 = sp[3];
            const float s0 = ((a0[0] + a0[1]) + (a0[2] + a0[3])) + ((a1[0] + a1[1]) + (a1[2] + a1[3])), s1 = ((b0[0] + b0[1]) + (b0[2] + b0[3])) + ((b1[0] + b1[1]) + (b1[2] + b1[3]));
            const float r0 = 1.0f / sqrtf(s0 * (1.0f / 512.0f) + eps), r1 = 1.0f / sqrtf(s1 * (1.0f / 512.0f) + eps);
            PG8_LAS float* tab = (PG8_LAS float*)(lds + STAGE_BYTES); tab[tid * 2] = r0 / r1; tab[tid * 2 + 1] = r1; }
    }
};

__device__ __forceinline__ unsigned cvt_pk_bf16(float lo, float hi) { unsigned r; asm volatile("v_cvt_pk_bf16_f32 %0, %1, %2" : "=v"(r) : "v"(lo), "v"(hi)); return r; }
typedef float f32x2 __attribute__((ext_vector_type(2)));
template <int ACT  > struct EpiBf16 {
    static constexpr bool PERM = true, AFTER_DRAIN = false, KSCALE = false;
    bf16_t* O; int ldc;
    __device__ __forceinline__ void operator()(const f32x4 (&acc)[2][2][4][2], const Unit& u, int wr, int wc, int fr, int fq) const {
        const int row0 = u.pm * BM + wr * 64 + fr; const int col0 = u.pn * BM + wc * 32 + 8 * fq;
#pragma unroll
        for (int ai = 0; ai < 2; ++ai)
#pragma unroll
            for (int m = 0; m < 4; ++m) { bf16_t* rowp = O + (size_t)(row0 + ai * HALF + m * 16) * ldc + col0;
#pragma unroll
                for (int bj = 0; bj < 2; ++bj) { f32x4 v0 = acc[ai][bj][m][0], v1 = acc[ai][bj][m][1];
                    if (ACT == 2) {
#pragma unroll
                        for (int j = 0; j < 4; ++j) { const float a = fmaxf(v0[j], 0.f), b = fmaxf(v1[j], 0.f); v0[j] = a * a; v1[j] = b * b; } }
                    u32x4 w; w.x = cvt_pk_bf16(v0[0], v0[1]); w.y = cvt_pk_bf16(v0[2], v0[3]); w.z = cvt_pk_bf16(v1[0], v1[1]); w.w = cvt_pk_bf16(v1[2], v1[3]);
                    *(u32x4*)(rowp + bj * HALF) = w; } }
    }
};
struct EpiResGate {
    static constexpr bool PERM = false, AFTER_DRAIN = false, KSCALE = false;
    const float* base; float* out; const float* gate; int rows_per_batch, gate_stride;
    __device__ __forceinline__ void operator()(const f32x4 (&acc)[2][2][4][2], const Unit& u, int wr, int wc, int fr, int fq) const {
        const int row0 = u.pm * BM + wr * 64 + fr, col0 = u.pn * BM + wc * 32 + 4 * fq;
        const float* gp = gate + (size_t)((u.pm * BM) / rows_per_batch) * gate_stride + col0;
        f32x4 gv[2][2];
#pragma unroll
        for (int bj = 0; bj < 2; ++bj)
#pragma unroll
            for (int n = 0; n < 2; ++n) gv[bj][n] = *(const f32x4*)(gp + bj * HALF + n * 16);
#pragma unroll
        for (int ai = 0; ai < 2; ++ai)
#pragma unroll
            for (int m = 0; m < 4; ++m) { const size_t off = (size_t)(row0 + ai * HALF + m * 16) * 1024 + col0;
#pragma unroll
                for (int bj = 0; bj < 2; ++bj)
#pragma unroll
                    for (int n = 0; n < 2; ++n) { const f32x4 bs = *(const f32x4*)(base + off + bj * HALF + n * 16); *(f32x4*)(out + off + bj * HALF + n * 16) = bs + gv[bj][n] * acc[ai][bj][m][n]; }
                asm volatile("" ::: "memory"); }
    }
};
struct EpiResGate2 {
    static constexpr bool PERM = false, AFTER_DRAIN = false, KSCALE = true; static constexpr int KS_T0 = 6, KS_T1 = 14;
    __device__ __forceinline__ void kscale(f32x4 (&acc)[2][2][4][2], PG8_LAS unsigned char* lds, int which, int wr, int fr) const {
        const PG8_LAS float* tab = (const PG8_LAS float*)(lds + STAGE_BYTES);
#pragma unroll
        for (int ai = 0; ai < 2; ++ai)
#pragma unroll
            for (int m = 0; m < 4; ++m) { const float f = tab[(ai * HALF + wr * 64 + m * 16 + fr) * 2 + which];
#pragma unroll
                for (int bj = 0; bj < 2; ++bj)
#pragma unroll
                    for (int n = 0; n < 2; ++n) acc[ai][bj][m][n] = acc[ai][bj][m][n] * f; }
    }
    const float* base; float* out; const float* gate; const float* gvec; const float* scale; bf16_t* xn; float* rowp; int rows_per_batch, gate_stride;
    __device__ __forceinline__ void operator()(const f32x4 (&acc)[2][2][4][2], const Unit& u, int wr, int wc, int fr, int fq) const {
        const int row0 = u.pm * BM + wr * 64 + fr, col0 = u.pn * BM + wc * 32 + 4 * fq;
        const size_t bofs = (size_t)((u.pm * BM) / rows_per_batch) * gate_stride + col0;
        f32x4 gv[2][2], gs[2][2];
#pragma unroll
        for (int bj = 0; bj < 2; ++bj)
#pragma unroll
            for (int n = 0; n < 2; ++n) { gv[bj][n] = *(const f32x4*)(gate + bofs + bj * HALF + n * 16);
                gs[bj][n] = *(const f32x4*)(gvec + col0 + bj * HALF + n * 16) * (*(const f32x4*)(scale + bofs + bj * HALF + n * 16) + 1.0f); }
#pragma unroll
        for (int ai = 0; ai < 2; ++ai)
#pragma unroll
            for (int m = 0; m < 4; ++m) { const int row = row0 + ai * HALF + m * 16; const size_t off = (size_t)row * 1024 + col0; float ss = 0.f;
#pragma unroll
                for (int bj = 0; bj < 2; ++bj)
#pragma unroll
                    for (int n = 0; n < 2; ++n) { const f32x4 bs = *(const f32x4*)(base + off + bj * HALF + n * 16); const f32x4 h = bs + gv[bj][n] * acc[ai][bj][m][n];
                        *(f32x4*)(out + off + bj * HALF + n * 16) = h; ss += (h[0] * h[0] + h[1] * h[1]) + (h[2] * h[2] + h[3] * h[3]);
                        const f32x4 av = h * gs[bj][n]; typedef unsigned u32x2v __attribute__((ext_vector_type(2))); u32x2v wv; wv.x = cvt_pk_bf16(av[0], av[1]); wv.y = cvt_pk_bf16(av[2], av[3]);
                        *(u32x2v*)(xn + off + bj * HALF + n * 16) = wv; }
                ss += __shfl_xor(ss, 16); ss += __shfl_xor(ss, 32);
                if (fq == 0) rowp[(size_t)row * 16 + u.pn * 4 + wc] = ss;
                asm volatile("" ::: "memory"); }
    }
};
struct EpiUp {
    static constexpr bool PERM = true, AFTER_DRAIN = false, KSCALE = false;
    bf16_t* O; int ldc; const float* rowp; const float* shw; int rows_per_batch; float inv_d, eps;
    __device__ __forceinline__ void operator()(const f32x4 (&acc)[2][2][4][2], const Unit& u, int wr, int wc, int fr, int fq) const {
        const int row0 = u.pm * BM + wr * 64 + fr; const int col0 = u.pn * BM + wc * 32 + 8 * fq;
        const float* sp = shw + (size_t)((u.pm * BM) / rows_per_batch) * ldc + col0;
        f32x4 bv[2][2];
#pragma unroll
        for (int bj = 0; bj < 2; ++bj)
#pragma unroll
            for (int n = 0; n < 2; ++n) bv[bj][n] = *(const f32x4*)(sp + bj * HALF + 4 * n);
#pragma unroll
        for (int ai = 0; ai < 2; ++ai)
#pragma unroll
            for (int m = 0; m < 4; ++m) { const int row = row0 + ai * HALF + m * 16; bf16_t* rowp_o = O + (size_t)row * ldc + col0;
                const f32x4* rp = (const f32x4*)(rowp + (size_t)row * 16); const f32x4 p0 = rp[0], p1 = rp[1], p2 = rp[2], p3 = rp[3];
                const float ss = (((p0[0] + p0[1]) + (p0[2] + p0[3])) + ((p1[0] + p1[1]) + (p1[2] + p1[3]))) + (((p2[0] + p2[1]) + (p2[2] + p2[3])) + ((p3[0] + p3[1]) + (p3[2] + p3[3])));
                const float rinv = 1.0f / sqrtf(ss * inv_d + eps);
#pragma unroll
                for (int bj = 0; bj < 2; ++bj) { f32x4 v0 = acc[ai][bj][m][0] * rinv + bv[bj][0], v1 = acc[ai][bj][m][1] * rinv + bv[bj][1];
#pragma unroll
                    for (int j = 0; j < 4; ++j) { const float a = fmaxf(v0[j], 0.f), b = fmaxf(v1[j], 0.f); v0[j] = a * a; v1[j] = b * b; }
                    u32x4 w; w.x = cvt_pk_bf16(v0[0], v0[1]); w.y = cvt_pk_bf16(v0[2], v0[3]); w.z = cvt_pk_bf16(v1[0], v1[1]); w.w = cvt_pk_bf16(v1[2], v1[3]);
                    *(u32x4*)(rowp_o + bj * HALF) = w; } }
    }
};
template <class Epi, class Sched, bool ALIGN_EPI = false, bool SP2 = false>
__device__ __forceinline__ void gemm_phase(PG8_LAS unsigned char* lds, const Gemm g, const Sched& S, const Epi& E) {
    const int tid = threadIdx.x, wid = __builtin_amdgcn_readfirstlane(tid >> 6), lane = tid & 63, wr = wid >> 2, wc = wid & 3, fr = lane & 15, fq = lane >> 4;
    const int K = g.K, nt = K / BK;
    unsigned voffA[2], voffB[2];
#pragma unroll
    for (int i = 0; i < 2; ++i) { int R, C; stage_rc(tid * 16 + i * 8192, R, C); const int Rb = Epi::PERM ? ((R & ~31) + perm32(R & 31)) : R;
        voffA[i] = (unsigned)(R * K + C) * 2u; voffB[i] = (unsigned)(Rb * K + C) * 2u; }
    const size_t kstep = (size_t)(BK * 2);
    const size_t hstep = (size_t)HALF * K * 2;
    const size_t tstep = 2 * hstep;
    const unsigned ldsw = (unsigned)wid * 1024u;
    const int aoff = lds_byte(wr * 64 + fr, fq * 8), boff = lds_byte(wc * 32 + fr, fq * 8);
#define PG8_SA(b, h) (((b) * 2 + (h)) * HTB)
#define PG8_SB(b, h) ((4 + (b) * 2 + (h)) * HTB)
#define PG8_STAGE(bufoff, gbase, voff) do { _Pragma("unroll") for (int _i = 0; _i < 2; ++_i) \
        __builtin_amdgcn_global_load_lds((const unsigned*)((const char*)(gbase) + (voff)[_i]), (PG8_LAS unsigned*)(lds + (bufoff) + ldsw + _i * 8192), 16, 0, 0); } while (0)
#define PG8_LDA(dst, b, h) do { _Pragma("unroll") for (int m = 0; m < 4; ++m) _Pragma("unroll") for (int k = 0; k < 2; ++k) dst[m][k] = *(const PG8_LAS bf16x8*)(lds + PG8_SA(b, h) + aoff + m * 2048 + k * 1024); } while (0)
#define PG8_LDB(dst, b, h) do { _Pragma("unroll") for (int n = 0; n < 2; ++n) _Pragma("unroll") for (int k = 0; k < 2; ++k) dst[n][k] = *(const PG8_LAS bf16x8*)(lds + PG8_SB(b, h) + boff + n * 2048 + k * 1024); } while (0)
#define PG8_MMA(ai, bj, At, Bt) do { __builtin_amdgcn_s_setprio(1); _Pragma("unroll") for (int m = 0; m < 4; ++m) _Pragma("unroll") for (int n = 0; n < 2; ++n) _Pragma("unroll") for (int k = 0; k < 2; ++k) \
        acc[ai][bj][m][n] = __builtin_amdgcn_mfma_f32_16x16x32_bf16(Bt[n][k], At[m][k], acc[ai][bj][m][n], 0, 0, 0); __builtin_amdgcn_s_setprio(0); } while (0)
#define PG8_WAIT_V(n) asm volatile("s_waitcnt vmcnt(" #n ")" ::: "memory")
#define PG8_WAIT_L(n) asm volatile("s_waitcnt lgkmcnt(" #n ")" ::: "memory")
#define PG8_BAR __builtin_amdgcn_s_barrier()
#define PG8_SCHED __builtin_amdgcn_sched_barrier(0)
    Unit cur, nxt; int ui = 0;
    if (!S.next(0, cur)) return;
    f32x4 acc[2][2][4][2];
#pragma unroll
    for (int a = 0; a < 2; ++a)
#pragma unroll
        for (int b = 0; b < 2; ++b)
#pragma unroll
            for (int m = 0; m < 4; ++m)
#pragma unroll
                for (int n = 0; n < 2; ++n) acc[a][b][m][n] = (f32x4){0.f, 0.f, 0.f, 0.f};
    bf16x8 At[4][2], B0[2][2], B1[2][2];
    const char* cA = (const char*)g.A + (size_t)cur.pm * tstep; const char* cB = (const char*)g.Bt + (size_t)cur.pn * tstep;
    S.a_ready(cur);
    if constexpr (SP2) {
        PG8_STAGE(PG8_SB(0, 0), cB, voffB); PG8_STAGE(PG8_SB(0, 1), cB + hstep, voffB); PG8_STAGE(PG8_SA(0, 0), cA, voffA); PG8_STAGE(PG8_SA(0, 1), cA + hstep, voffA);
        if (wr == 1) PG8_BAR;
        PG8_WAIT_V(2); PG8_BAR;
        PG8_STAGE(PG8_SB(1, 0), cB + kstep, voffB); PG8_STAGE(PG8_SA(1, 0), cA + kstep, voffA); PG8_STAGE(PG8_SB(1, 1), cB + hstep + kstep, voffB);
        PG8_WAIT_V(6); PG8_BAR;
    } else {
        PG8_STAGE(PG8_SB(0, 0), cB, voffB); PG8_STAGE(PG8_SA(0, 0), cA, voffA); PG8_STAGE(PG8_SB(0, 1), cB + hstep, voffB); PG8_STAGE(PG8_SA(0, 1), cA + hstep, voffA);
        if (wr == 1) PG8_BAR;
        PG8_WAIT_V(4); PG8_BAR;
        PG8_STAGE(PG8_SB(1, 0), cB + kstep, voffB); PG8_STAGE(PG8_SA(1, 0), cA + kstep, voffA); PG8_STAGE(PG8_SB(1, 1), cB + hstep + kstep, voffB);
        PG8_WAIT_V(6); PG8_BAR;
    }
    for (;;) {
        const bool has_next = S.next(ui + 1, nxt);
        const char* nA = has_next ? (const char*)g.A + (size_t)nxt.pm * tstep : cA; const char* nB = has_next ? (const char*)g.Bt + (size_t)nxt.pn * tstep : cB;
        for (int t = 0; t < nt; t += 2) {
            const bool last = (t == nt - 2);
            const char* a1 = cA + (size_t)(t + 1) * kstep;
            const char* a2 = last ? nA : cA + (size_t)(t + 2) * kstep; const char* b2 = last ? nB : cB + (size_t)(t + 2) * kstep;
            const char* a3 = a2 + kstep; const char* b3 = b2 + kstep;
            if (last && has_next) S.a_ready(nxt);
            if constexpr (SP2) {
            PG8_LDB(B0, 0, 0); PG8_LDB(B1, 0, 1); PG8_SCHED; PG8_LDA(At, 0, 0); PG8_STAGE(PG8_SA(1, 1), a1 + hstep, voffA);
            PG8_WAIT_V(8); PG8_WAIT_L(0); PG8_BAR; PG8_MMA(0, 0, At, B0); PG8_MMA(0, 1, At, B1); PG8_BAR; PG8_SCHED;
            PG8_LDA(At, 0, 1); PG8_STAGE(PG8_SB(0, 0), b2, voffB); PG8_STAGE(PG8_SB(0, 1), b2 + hstep, voffB); PG8_STAGE(PG8_SA(0, 0), a2, voffA);
            PG8_WAIT_V(8); PG8_WAIT_L(0); PG8_BAR; PG8_MMA(1, 0, At, B0); PG8_MMA(1, 1, At, B1); PG8_BAR; PG8_SCHED;
            PG8_LDB(B0, 1, 0); PG8_LDB(B1, 1, 1); PG8_SCHED; PG8_LDA(At, 1, 0); PG8_STAGE(PG8_SA(0, 1), a2 + hstep, voffA);
            PG8_WAIT_V(8); PG8_WAIT_L(0); PG8_BAR; PG8_MMA(0, 0, At, B0); PG8_MMA(0, 1, At, B1); PG8_BAR; PG8_SCHED;
            PG8_LDA(At, 1, 1); PG8_STAGE(PG8_SB(1, 0), b3, voffB); PG8_STAGE(PG8_SB(1, 1), b3 + hstep, voffB); PG8_STAGE(PG8_SA(1, 0), a3, voffA);
            PG8_WAIT_V(8); PG8_WAIT_L(0); PG8_BAR; PG8_MMA(1, 0, At, B0); PG8_MMA(1, 1, At, B1); PG8_BAR; PG8_SCHED;
            if constexpr (Epi::KSCALE) { if (t == Epi::KS_T0 || t == Epi::KS_T1) { E.kscale(acc, lds, t == Epi::KS_T1 ? 1 : 0, wr, fr); PG8_SCHED; } }
            } else {
            PG8_LDB(B0, 0, 0); PG8_SCHED; PG8_LDA(At, 0, 0); PG8_STAGE(PG8_SA(1, 1), a1 + hstep, voffA);
            PG8_WAIT_L(8); PG8_BAR; PG8_WAIT_L(0); PG8_MMA(0, 0, At, B0); PG8_BAR; PG8_SCHED;
            PG8_LDB(B1, 0, 1); PG8_STAGE(PG8_SB(0, 0), b2, voffB);
            PG8_BAR; PG8_WAIT_L(0); PG8_MMA(0, 1, At, B1); PG8_BAR;
            PG8_LDA(At, 0, 1); PG8_STAGE(PG8_SA(0, 0), a2, voffA);
            PG8_BAR; PG8_WAIT_L(0); PG8_MMA(1, 0, At, B0); PG8_BAR; PG8_SCHED;
            PG8_STAGE(PG8_SB(0, 1), b2 + hstep, voffB);
            PG8_WAIT_V(6); PG8_BAR; PG8_MMA(1, 1, At, B1); PG8_BAR;
            PG8_LDB(B0, 1, 0); PG8_SCHED; PG8_LDA(At, 1, 0); PG8_STAGE(PG8_SA(0, 1), a2 + hstep, voffA);
            PG8_WAIT_L(8); PG8_BAR; PG8_WAIT_L(0); PG8_MMA(0, 0, At, B0); PG8_BAR; PG8_SCHED;
            PG8_LDB(B1, 1, 1); PG8_STAGE(PG8_SB(1, 0), b3, voffB);
            PG8_BAR; PG8_WAIT_L(0); PG8_MMA(0, 1, At, B1); PG8_BAR;
            PG8_LDA(At, 1, 1); PG8_STAGE(PG8_SA(1, 0), a3, voffA);
            PG8_BAR; PG8_WAIT_L(0); PG8_MMA(1, 0, At, B0); PG8_BAR; PG8_SCHED;
            PG8_STAGE(PG8_SB(1, 1), b3 + hstep, voffB);
            PG8_WAIT_V(6); PG8_BAR; PG8_MMA(1, 1, At, B1); PG8_BAR;
            }
        }
        if constexpr (ALIGN_EPI) { if (wr == 0) PG8_BAR; }
        if constexpr (!Epi::AFTER_DRAIN) { E(acc, cur, wr, wc, fr, fq); S.done(cur); }
        if (!has_next) break;
#pragma unroll
        for (int a = 0; a < 2; ++a)
#pragma unroll
            for (int b = 0; b < 2; ++b)
#pragma unroll
                for (int m = 0; m < 4; ++m)
#pragma unroll
                    for (int n = 0; n < 2; ++n) acc[a][b][m][n] = (f32x4){0.f, 0.f, 0.f, 0.f};
        cur = nxt; cA = nA; cB = nB; ++ui;
        if constexpr (ALIGN_EPI) { if (wr == 1) PG8_BAR; }
    }
    PG8_WAIT_V(0);
    if constexpr (!ALIGN_EPI) { if (wr == 0) PG8_BAR; }
    PG8_BAR;
    if constexpr (Epi::AFTER_DRAIN) { E.fused(acc, cur, wr, wc, fr, fq, lds, wid, lane); S.done(cur); }
#undef PG8_SA
#undef PG8_SB
#undef PG8_STAGE
#undef PG8_LDA
#undef PG8_LDB
#undef PG8_MMA
#undef PG8_WAIT_V
#undef PG8_WAIT_L
#undef PG8_BAR
#undef PG8_SCHED
}
}
#define LAS __attribute__((address_space(3)))
typedef unsigned short bf16;
typedef unsigned v4u __attribute__((ext_vector_type(4)));
typedef unsigned v2u __attribute__((ext_vector_type(2)));
typedef float f32x4 __attribute__((ext_vector_type(4)));
constexpr int D = 1024, BATCH = 16, SEQ = 2048, M = BATCH * SEQ;
constexpr int NHEADS = 16, HD = 64, NST = 128, CONVCH = 1536, MIXW = 1536, INW = 3088, NPROJ = 3072, FF = 4096, NMOD = 6 * D;
constexpr float EPS = 1e-5f;
constexpr int NWAVES = 8, NTHR = 512;
constexpr int LDS_BYTES = 147456;
constexpr size_t MiB = 1u << 20;
constexpr size_t WS_MOD = 0, WS_BAR = 512 * 1024, WS_SHW = 1 * MiB, WS_ROWP = 480 * MiB, WS_DT = 2 * MiB, WS_SSQ = 4 * MiB, WS_WIN = 6 * MiB, WS_WOUT = 12 * MiB, WS_WUP = 16 * MiB, WS_WDN = 24 * MiB;
constexpr size_t WS_XN = 32 * MiB, WS_PROJ = 96 * MiB, WS_CONV = 288 * MiB, WS_YMIX = 384 * MiB, WS_F = 96 * MiB, WS_END = 482 * MiB;

__device__ __forceinline__ unsigned f2bf(float f) { unsigned u = __float_as_uint(f); return (u + 0x7fffu + ((u >> 16) & 1u)) >> 16; }
__device__ __forceinline__ unsigned pk2(float lo, float hi) { unsigned r; asm("v_cvt_pk_bf16_f32 %0, %1, %2" : "=v"(r) : "v"(lo), "v"(hi)); return r; }
__device__ __forceinline__ float bflo(unsigned w) { return __uint_as_float(w << 16); }
__device__ __forceinline__ float bfhi(unsigned w) { return __uint_as_float(w & 0xffff0000u); }
__device__ __forceinline__ void unpack8(const v4u w, float (&f)[8]) { f[0] = bflo(w.x); f[1] = bfhi(w.x); f[2] = bflo(w.y); f[3] = bfhi(w.y); f[4] = bflo(w.z); f[5] = bfhi(w.z); f[6] = bflo(w.w); f[7] = bfhi(w.w); }
__device__ __forceinline__ v4u pack8(const float (&f)[8]) { v4u w; w.x = pk2(f[0], f[1]); w.y = pk2(f[2], f[3]); w.z = pk2(f[4], f[5]); w.w = pk2(f[6], f[7]); return w; }
__device__ __forceinline__ float wave_sum(float v) {
#pragma unroll
    for (int o = 1; o < 64; o <<= 1) v += __shfl_xor(v, o);
    return v;
}
__device__ __forceinline__ float silu_f(float v) { return v * __builtin_amdgcn_rcpf(1.f + __builtin_amdgcn_exp2f(-1.44269504f * v)); }
__device__ __forceinline__ float softplus_f(float v) { return fmaxf(v, 0.f) + log1pf(__expf(-fabsf(v))); }

struct Args { const float* in[19]; float* out; unsigned char* ws; int ph_lo, ph_hi; };

__device__ __forceinline__ void transpose_item(const float* W, int ldw, int col0, int K, bf16* WT, int row_off, LAS float* scr, int kb, int nb, int lane, int src_row_off = 0, const float* kscale = nullptr) {
    const int k0 = 64 * kb, n0 = 32 * nb;
#pragma unroll 8
    for (int i = 0; i < 32; ++i) { const int kk = 2 * i + (lane >> 5); const float sc = kscale ? kscale[k0 + kk] : 1.0f; scr[kk * 33 + (lane & 31)] = sc * W[(size_t)(src_row_off + k0 + kk) * ldw + col0 + n0 + (lane & 31)]; }
    asm volatile("s_waitcnt lgkmcnt(0)" ::: "memory");
    const int c = lane & 7;
#pragma unroll
    for (int j = 0; j < 4; ++j) { const int n = (lane >> 3) + 8 * j; const LAS float* s = scr + (8 * c) * 33 + n;
        v4u o; o.x = pk2(s[0 * 33], s[1 * 33]); o.y = pk2(s[2 * 33], s[3 * 33]); o.z = pk2(s[4 * 33], s[5 * 33]); o.w = pk2(s[6 * 33], s[7 * 33]);
        *(v4u*)(WT + (size_t)(row_off + n0 + n) * K + k0 + 8 * c) = o; }
    asm volatile("s_waitcnt lgkmcnt(0)" ::: "memory");
}

template <bool SILU>
__device__ __forceinline__ void small_proj(LAS unsigned char* lds, const float* src, int sstride, const float* W, int ldw, int ncols, const float* bias, float* out, int ostride, int G) {
    const int tid = threadIdx.x, lane = tid & 63, wave = tid >> 6, nitems = ncols / 32;
    LAS float* cst = (LAS float*)lds;
    LAS float* part = (LAS float*)(lds + 65536);
    if ((int)blockIdx.x < nitems) {
        for (int i = tid; i < 16384; i += NTHR) { const int b = i >> 10, k = i & 1023; const float v = src[(size_t)b * sstride + k]; cst[k * 16 + b] = SILU ? silu_f(v) : v; }
        __syncthreads();
    }
    for (int it = blockIdx.x; it < nitems; it += G) {
        const int col0 = it * 32, kh = lane >> 5, col = lane & 31, kbase = wave * 128 + kh * 64;
        float acc[16];
#pragma unroll
        for (int b = 0; b < 16; ++b) acc[b] = 0.f;
#pragma unroll 8
        for (int i = 0; i < 64; ++i) {
            const int k = kbase + i; const float wv = W[(size_t)k * ldw + col0 + col];
#pragma unroll
            for (int q = 0; q < 4; ++q) { const f32x4 c4 = *(const LAS f32x4*)(cst + k * 16 + 4 * q); acc[4 * q + 0] += c4.x * wv; acc[4 * q + 1] += c4.y * wv; acc[4 * q + 2] += c4.z * wv; acc[4 * q + 3] += c4.w * wv; }
        }
#pragma unroll
        for (int b = 0; b < 16; ++b) part[((wave * 2 + kh) * 16 + b) * 32 + col] = acc[b];
        __syncthreads();
        { const int b = tid >> 5, cc = tid & 31; float sm = bias ? bias[col0 + cc] : 0.f;
#pragma unroll
          for (int p = 0; p < 16; ++p) sm += part[(p * 16 + b) * 32 + cc];
          out[(size_t)b * ostride + col0 + cc] = sm; }
        __syncthreads();
    }
    __syncthreads();
}

__device__ __forceinline__ void p0_prologue(LAS unsigned char* lds, const Args& a, int G) {
    const int tid = threadIdx.x, lane = tid & 63, wave = tid >> 6;
    unsigned char* ws = a.ws;
    const float* w_in = a.in[5];
    bf16* WtIn = (bf16*)(ws + WS_WIN);
    {
        LAS float* wp = (LAS float*)lds;
        LAS float* win = (LAS float*)(lds + 65536);
        for (int it = blockIdx.x; it < 256; it += G) {
            const int g = it >> 6, k0 = (it & 63) * 16;
            const float* wpg = a.in[12] + (size_t)g * 16384;
            for (int i = tid; i < 16384; i += NTHR) wp[i] = wpg[i];
            for (int i = tid; i < 2048; i += NTHR) { const int kk = i >> 7, c = i & 127; win[i] = w_in[(size_t)(k0 + kk) * INW + g * 128 + c]; }
            __syncthreads();
            const int kk = tid >> 5, d4 = (tid & 31) * 4;
            f32x4 acc = {0.f, 0.f, 0.f, 0.f};
#pragma unroll 8
            for (int c = 0; c < 128; ++c) { const float av = win[kk * 128 + c]; const f32x4 w4 = *(const LAS f32x4*)(wp + c * 128 + d4); acc += av * w4; }
#pragma unroll
            for (int e = 0; e < 4; ++e) WtIn[(size_t)(g * 128 + d4 + e) * D + k0 + kk] = (bf16)f2bf(acc[e]);
            __syncthreads();
        }
    }
    small_proj<true>(lds, a.in[1], D, a.in[2], NMOD, NMOD, a.in[3], (float*)(ws + WS_MOD), NMOD, G);
    __syncthreads();
    {
        LAS float* scr = (LAS float*)(lds + wave * 16384);
        const int gw = blockIdx.x * NWAVES + wave, NGW = G * NWAVES;
        constexpr int I_IN = 16 * 80, I_OUT = 24 * 32, I_UP = 16 * 128, I_DN = 64 * 32;
        for (int it = gw; it < I_IN + I_OUT + I_UP + I_DN; it += NGW) {
            int r = it;
            if (r < I_IN) { transpose_item(w_in, INW, 512, D, WtIn, 512, scr, r / 80, r % 80, lane); continue; } r -= I_IN;
            if (r < I_OUT) { const int kb = r / 32;
                transpose_item(a.in[14], D, 0, MIXW, (bf16*)(ws + WS_WOUT), 0, scr, kb, r % 32, lane, kb < 16 ? 512 : -1024, kb < 16 ? a.in[11] : nullptr); continue; } r -= I_OUT;
            if (r < I_UP) { transpose_item(a.in[16], FF, 0, D, (bf16*)(ws + WS_WUP), 0, scr, r / 128, r % 128, lane); continue; } r -= I_UP;
            transpose_item(a.in[17], D, 0, FF, (bf16*)(ws + WS_WDN), 0, scr, r / 32, r % 32, lane);
        }
    }
}

template <bool WITH_DT>
__device__ __forceinline__ void normmod_phase(LAS unsigned char* lds, const float* src, const float* gvec, const float* MOD, int shift_ofs, int scale_ofs, bf16* XN,
                                              const float* w_in, const float* dt_bias, float* DT, int G) {
    const int tid = threadIdx.x, lane = tid & 63, wave = tid >> 6;
    LAS float* WdtL = (LAS float*)lds;
    if (WITH_DT) {
        for (int i = tid; i < 16384; i += NTHR) { const int k = i >> 4, h = i & 15; WdtL[h * 1024 + k] = w_in[(size_t)k * INW + NPROJ + h]; }
        __syncthreads();
    }
    const int gw = blockIdx.x * NWAVES + wave, NGW = G * NWAVES;
    for (int rg = gw; rg < M / 16; rg += NGW) {
        const int m0 = rg * 16, b = m0 / SEQ;
        const float* mp = MOD + (size_t)b * NMOD;
        f32x4 gs[4], sh[4];
#pragma unroll
        for (int j = 0; j < 4; ++j) { const int k = 4 * lane + 256 * j; const f32x4 g4 = *(const f32x4*)(gvec + k); const f32x4 sc = *(const f32x4*)(mp + scale_ofs + k); gs[j] = g4 * (sc + 1.0f); sh[j] = *(const f32x4*)(mp + shift_ofs + k); }
        for (int r = 0; r < 16; ++r) {
            const int m = m0 + r;
            const f32x4* xr = (const f32x4*)(src + (size_t)m * D) + lane;
            f32x4 v[4]; float ss = 0.f;
#pragma unroll
            for (int j = 0; j < 4; ++j) { v[j] = xr[64 * j]; ss += (v[j].x * v[j].x + v[j].y * v[j].y) + (v[j].z * v[j].z + v[j].w * v[j].w); }
            ss = wave_sum(ss);
            const float rinv = 1.0f / sqrtf(ss * (1.0f / D) + EPS);
#pragma unroll
            for (int j = 0; j < 4; ++j) v[j] = v[j] * rinv * gs[j] + sh[j];
            unsigned long long* o8 = (unsigned long long*)(XN + (size_t)m * D) + lane;
#pragma unroll
            for (int j = 0; j < 4; ++j) o8[64 * j] = (unsigned long long)pk2(v[j].x, v[j].y) | ((unsigned long long)pk2(v[j].z, v[j].w) << 32);
            if (WITH_DT) {
                float acc[16];
#pragma unroll
                for (int h = 0; h < 16; ++h) { float s = 0.f;
#pragma unroll
                    for (int j = 0; j < 4; ++j) { const f32x4 w4 = *(const LAS f32x4*)(WdtL + h * 1024 + 4 * lane + 256 * j); s += (v[j].x * w4.x + v[j].y * w4.y) + (v[j].z * w4.z + v[j].w * w4.w); }
                    acc[h] = s; if ((h & 3) == 3) asm volatile("" ::: "memory"); }
                float a8[8], a4[4], a2[2], a1;
                const bool u5 = (lane & 32) != 0, u4 = (lane & 16) != 0, u3 = (lane & 8) != 0, u2 = (lane & 4) != 0;
#pragma unroll
                for (int i = 0; i < 8; ++i) { const float keep = u5 ? acc[i + 8] : acc[i], send = u5 ? acc[i] : acc[i + 8]; a8[i] = keep + __shfl_xor(send, 32); }
#pragma unroll
                for (int i = 0; i < 4; ++i) { const float keep = u4 ? a8[i + 4] : a8[i], send = u4 ? a8[i] : a8[i + 4]; a4[i] = keep + __shfl_xor(send, 16); }
#pragma unroll
                for (int i = 0; i < 2; ++i) { const float keep = u3 ? a4[i + 2] : a4[i], send = u3 ? a4[i] : a4[i + 2]; a2[i] = keep + __shfl_xor(send, 8); }
                { const float keep = u2 ? a2[1] : a2[0], send = u2 ? a2[0] : a2[1]; a1 = keep + __shfl_xor(send, 4); }
                a1 += __shfl_xor(a1, 2); a1 += __shfl_xor(a1, 1);
                const int h = ((lane >> 5) & 1) * 8 + ((lane >> 4) & 1) * 4 + ((lane >> 3) & 1) * 2 + ((lane >> 2) & 1);
                if ((lane & 3) == 0) DT[(size_t)m * 16 + h] = softplus_f(a1 + dt_bias[h]);
            }
        }
    }
}

template <int TAPS, bool POOL>
__device__ __forceinline__ void fir_rows(const Args& a, int G, int cgi, int rsub) {
    const bf16* PROJ = (const bf16*)(a.ws + WS_PROJ);
    const int c0 = cgi * 8;
    const bf16* src = PROJ + (POOL ? 0 : 1536) + c0;
    bf16* dst = POOL ? (bf16*)(a.ws + WS_YMIX) + 1024 + c0 : (bf16*)(a.ws + WS_CONV) + c0;
    const int dstride = POOL ? MIXW : CONVCH;
    const int w = POOL ? (2 << (c0 >> 7)) : 4;
    float pa[8], pb[4][8];
#pragma unroll
    for (int e = 0; e < 8; ++e) { pa[e] = POOL ? a.in[13][c0 + e] : a.in[7][c0 + e];
#pragma unroll
        for (int k = 0; k < 4; ++k) pb[k][e] = POOL ? 0.f : a.in[6][k * CONVCH + c0 + e]; }
    for (int blk = blockIdx.x; blk < M / 128; blk += G)
        for (int i = 0; i < 16; ++i) {
            const int m0 = blk * 128 + (i * 2 + rsub) * 4, s0 = m0 & (SEQ - 1);
            v4u L[TAPS + 3];
#pragma unroll
            for (int r = 0; r < TAPS + 3; ++r) { const int rel = r - (TAPS - 1);
                if (s0 + rel >= 0) L[r] = *(const v4u*)(src + (size_t)(m0 + rel) * NPROJ); else L[r] = (v4u){0u, 0u, 0u, 0u}; }
#pragma unroll
            for (int o = 0; o < 4; ++o) {
                float acc[8];
                if (POOL) {
                    const int nv = min(s0 + o + 1, w); const float inv = 1.0f / (float)nv;
#pragma unroll
                    for (int e = 0; e < 8; ++e) acc[e] = 0.f;
#pragma unroll
                    for (int j = 0; j < TAPS; ++j) { float t[8]; unpack8(L[TAPS - 1 + o - j], t); const float cj = (j < nv) ? 1.0f : 0.0f;
#pragma unroll
                        for (int e = 0; e < 8; ++e) acc[e] += cj * t[e]; }
                    float cur[8]; unpack8(L[TAPS - 1 + o], cur);
#pragma unroll
                    for (int e = 0; e < 8; ++e) acc[e] = (acc[e] * inv - cur[e]) * pa[e];
                } else {
#pragma unroll
                    for (int e = 0; e < 8; ++e) acc[e] = pa[e];
#pragma unroll
                    for (int k = 0; k < 4; ++k) { float t[8]; unpack8(L[o + k], t);
#pragma unroll
                        for (int e = 0; e < 8; ++e) acc[e] += pb[k][e] * t[e]; }
#pragma unroll
                    for (int e = 0; e < 8; ++e) acc[e] = silu_f(acc[e]);
                }
                *(v4u*)(dst + (size_t)(m0 + o) * dstride) = pack8(acc);
            }
        }
}
__device__ __forceinline__ void halo_phase(const Args& a, int G) {
    const int tid = threadIdx.x, cgp = tid & 255, rsub = tid >> 8;
    if (cgp < 64) fir_rows<16, true>(a, G, cgp, rsub); else fir_rows<4, false>(a, G, cgp - 64, rsub);
}

__device__ __forceinline__ void ssd_naive_phase(LAS unsigned char* lds, const Args& a, int G) {
    const int tid = threadIdx.x;
    LAS float* xs = (LAS float*)lds;
    LAS float* Bs = (LAS float*)(lds + 16384);
    LAS float* Cs = (LAS float*)(lds + 49152);
    LAS float* yb = (LAS float*)(lds + 81920);
    LAS float* dts = (LAS float*)(lds + 98304);
    LAS float* dAs = (LAS float*)(lds + 98304 + 256);
    const bf16* PROJ = (const bf16*)(a.ws + WS_PROJ); const bf16* CONV = (const bf16*)(a.ws + WS_CONV);
    bf16* YMIX = (bf16*)(a.ws + WS_YMIX); const float* DT = (const float*)(a.ws + WS_DT); float* SSQ = (float*)(a.ws + WS_SSQ);
    const int p = tid >> 3, nq = tid & 7, n0 = nq * 16;
    for (int it = blockIdx.x; it < BATCH * NHEADS; it += G) {
        const int b = it >> 4, hh = it & 15, g = hh >> 3;
        const float av = -__expf(a.in[9][hh]), dsk = a.in[10][hh];
        float h[16];
#pragma unroll
        for (int i = 0; i < 16; ++i) h[i] = 0.f;
        for (int ck = 0; ck < SEQ / 64; ++ck) {
            const size_t m0 = (size_t)b * SEQ + ck * 64;
            { const int t = tid >> 3, part = tid & 7; float f[8]; unpack8(*(const v4u*)(CONV + (m0 + t) * CONVCH + hh * 64 + part * 8), f);
#pragma unroll
              for (int e = 0; e < 8; ++e) xs[t * 64 + part * 8 + e] = f[e]; }
#pragma unroll
            for (int i = 0; i < 2; ++i) { const int piece = tid + i * NTHR, t = piece >> 4, part = piece & 15; float f[8];
                unpack8(*(const v4u*)(CONV + (m0 + t) * CONVCH + 1024 + g * 128 + part * 8), f);
#pragma unroll
                for (int e = 0; e < 8; ++e) Bs[t * 128 + part * 8 + e] = f[e];
                unpack8(*(const v4u*)(CONV + (m0 + t) * CONVCH + 1280 + g * 128 + part * 8), f);
#pragma unroll
                for (int e = 0; e < 8; ++e) Cs[t * 128 + part * 8 + e] = f[e]; }
            if (tid < 64) { const float dtv = DT[(m0 + tid) * 16 + hh]; dts[tid] = dtv; dAs[tid] = __expf(dtv * av); }
            __syncthreads();
            for (int t = 0; t < 64; ++t) {
                const float xr = xs[t * 64 + p], xv = xr * dts[t], dA = dAs[t];
                float yp = 0.f;
#pragma unroll
                for (int q = 0; q < 4; ++q) { const f32x4 b4 = *(const LAS f32x4*)(Bs + t * 128 + n0 + 4 * q), c4 = *(const LAS f32x4*)(Cs + t * 128 + n0 + 4 * q);
#pragma unroll
                    for (int e = 0; e < 4; ++e) { h[4 * q + e] = h[4 * q + e] * dA + xv * b4[e]; yp += h[4 * q + e] * c4[e]; } }
                yp += __shfl_xor(yp, 1); yp += __shfl_xor(yp, 2); yp += __shfl_xor(yp, 4);
                if (nq == 0) yb[t * 64 + p] = yp + dsk * xr;
            }
            __syncthreads();
            { const int t = tid >> 3, part = tid & 7; float z[8], y[8]; unpack8(*(const v4u*)(PROJ + (m0 + t) * NPROJ + 512 + hh * 64 + part * 8), z);
              float sq = 0.f;
#pragma unroll
              for (int e = 0; e < 8; ++e) { y[e] = yb[t * 64 + part * 8 + e] * silu_f(z[e]); sq += y[e] * y[e]; }
              sq += __shfl_xor(sq, 1); sq += __shfl_xor(sq, 2); sq += __shfl_xor(sq, 4);
              if (part == 0) SSQ[(m0 + t) * 16 + hh] = sq;
              *(v4u*)(YMIX + (m0 + t) * MIXW + 512 + hh * 64 + part * 8) = pack8(y); }
            __syncthreads();
        }
    }
}

typedef short s16x4 __attribute__((ext_vector_type(4)));
typedef short bf16x8 __attribute__((ext_vector_type(8)));
__device__ __forceinline__ bf16x8 frag_row(LAS unsigned char* base, int stride, int row0, int k0, int x, int y) { return *(const LAS bf16x8*)(base + (row0 + x) * stride + (k0 + 8 * y) * 2); }
__device__ __forceinline__ bf16x8 frag_tr(LAS unsigned char* base, int stride, int krow0, int col0, int lane) {
    const int y = lane >> 4, q = (lane >> 2) & 3, p = lane & 3;
    LAS unsigned char* a0 = base + (krow0 + 4 * y + q) * stride + (col0 + 4 * p) * 2;
    const s16x4 r0 = __builtin_amdgcn_ds_read_tr16_b64_v4i16((LAS s16x4*)a0);
    const s16x4 r1 = __builtin_amdgcn_ds_read_tr16_b64_v4i16((LAS s16x4*)(a0 + 16 * stride));
    return __builtin_shufflevector(r0, r1, 0, 1, 2, 3, 4, 5, 6, 7);
}
__device__ __forceinline__ void ssd_chunk_phase(LAS unsigned char* lds, const Args& a, int G) {
    const int tid = threadIdx.x, lane = tid & 63, w = __builtin_amdgcn_readfirstlane(tid >> 6), x = lane & 15, y = lane >> 4;
    constexpr int CS = 0, CSS = 272, BS = 34816, BSS = 288, XS = 71680, XSS = 160, XW = 92160, HB = 112640, HBS = 272, TAB = 130048;
    LAS float* t_acum = (LAS float*)(lds + TAB); LAS float* t_dt = t_acum + 128; LAS float* t_ea = t_acum + 256; LAS float* t_wl = t_acum + 384; LAS float* t_misc = t_acum + 512;
    const bf16* PROJ = (const bf16*)(a.ws + WS_PROJ); const bf16* CONV = (const bf16*)(a.ws + WS_CONV);
    bf16* YMIX = (bf16*)(a.ws + WS_YMIX); const float* DT = (const float*)(a.ws + WS_DT); float* SSQ = (float*)(a.ws + WS_SSQ);
    for (int it0 = blockIdx.x; it0 < BATCH * NHEADS; it0 += G) {
        const int xcd = it0 & 7, slot = it0 >> 3, qq = xcd * 4 + (slot >> 3), b = qq >> 1, g = qq & 1, hh = g * 8 + (slot & 7);
        const float av = -__expf(a.in[9][hh]), dsk = a.in[10][hh];
        f32x4 hst[4];
#pragma unroll
        for (int nt = 0; nt < 4; ++nt) hst[nt] = (f32x4){0.f, 0.f, 0.f, 0.f};
        v4u rc[4], rb[4], rx[2]; float d0 = 0.f, d1 = 0.f;
        const bf16* cbase = CONV + (size_t)b * SEQ * CONVCH;
#define SSD_LOAD(ck_) do { const bf16* cb_ = cbase + (size_t)(ck_) * 128 * CONVCH; \
            _Pragma("unroll") for (int i = 0; i < 4; ++i) { const int piece = tid + i * NTHR, row = piece >> 4, part = piece & 15; \
                rc[i] = *(const v4u*)(cb_ + (size_t)row * CONVCH + 1280 + g * 128 + part * 8); rb[i] = *(const v4u*)(cb_ + (size_t)row * CONVCH + 1024 + g * 128 + part * 8); } \
            _Pragma("unroll") for (int i = 0; i < 2; ++i) { const int piece = tid + i * NTHR, row = piece >> 3, part = piece & 7; rx[i] = *(const v4u*)(cb_ + (size_t)row * CONVCH + hh * 64 + part * 8); } \
            if (w == 0) { const size_t mm_ = (size_t)b * SEQ + (ck_) * 128 + 2 * lane; d0 = DT[mm_ * 16 + hh]; d1 = DT[(mm_ + 1) * 16 + hh]; } } while (0)
        SSD_LOAD(0);
        for (int ck = 0; ck < SEQ / 128; ++ck) {
            const size_t m0 = (size_t)b * SEQ + ck * 128;
            const int lt = (w < 4) ? w : 11 - w;
            const int l = 16 * lt + x;
            v2u rz[4];
#pragma unroll
            for (int pt = 0; pt < 4; ++pt) rz[pt] = *(const v2u*)(PROJ + (m0 + l) * NPROJ + 512 + hh * 64 + 16 * pt + 4 * y);
            if (w == 0) {
                const float a0 = d0 * av, a1 = d1 * av; float sc = a0 + a1;
#pragma unroll
                for (int o = 1; o < 64; o <<= 1) { const float t = __shfl_up(sc, o); if (lane >= o) sc += t; }
                const float c1 = sc, c0 = sc - a1, alast = __shfl(sc, 63);
                t_acum[2 * lane] = c0; t_acum[2 * lane + 1] = c1; t_dt[2 * lane] = d0; t_dt[2 * lane + 1] = d1;
                t_ea[2 * lane] = __expf(c0); t_ea[2 * lane + 1] = __expf(c1);
                t_wl[2 * lane] = d0 * __expf(alast - c0); t_wl[2 * lane + 1] = d1 * __expf(alast - c1);
                if (lane == 0) t_misc[0] = __expf(alast);
            }
#pragma unroll
            for (int i = 0; i < 4; ++i) { const int piece = tid + i * NTHR, row = piece >> 4, part = piece & 15;
                *(LAS v4u*)(lds + CS + row * CSS + part * 16) = rc[i]; *(LAS v4u*)(lds + BS + row * BSS + part * 16) = rb[i]; }
#pragma unroll
            for (int i = 0; i < 2; ++i) { const int piece = tid + i * NTHR, row = piece >> 3, part = piece & 7; *(LAS v4u*)(lds + XS + row * XSS + part * 16) = rx[i]; }
#pragma unroll
            for (int nt = 0; nt < 4; ++nt) { const int p = 16 * (w & 3) + x, n = 16 * (4 * (w >> 2) + nt) + 4 * y;
                *(LAS v2u*)(lds + HB + p * HBS + n * 2) = (v2u){pk2(hst[nt].x, hst[nt].y), pk2(hst[nt].z, hst[nt].w)}; }
            __syncthreads();
#pragma unroll
            for (int i = 0; i < 2; ++i) { const int piece = tid + i * NTHR, row = piece >> 3, part = piece & 7; const float wl = t_wl[row]; float f[8]; unpack8(rx[i], f);
#pragma unroll
                for (int e = 0; e < 8; ++e) f[e] *= wl;
                *(LAS v4u*)(lds + XW + row * XSS + part * 16) = pack8(f); }
            __syncthreads();
            if (ck + 1 < SEQ / 128) SSD_LOAD(ck + 1);
            bf16x8 cf[4];
#pragma unroll
            for (int ks = 0; ks < 4; ++ks) cf[ks] = frag_row(lds + CS, CSS, 16 * lt, 32 * ks, x, y);
            f32x4 sacc[8];
#pragma unroll
            for (int ts = 0; ts < 8; ++ts) { sacc[ts] = (f32x4){0.f, 0.f, 0.f, 0.f};
                if (ts <= lt) {
#pragma unroll
                for (int ks = 0; ks < 4; ++ks) sacc[ts] = __builtin_amdgcn_mfma_f32_16x16x32_bf16(frag_row(lds + BS, BSS, 16 * ts, 32 * ks, x, y), cf[ks], sacc[ts], 0, 0, 0); } }
            f32x4 yacc[4];
            const float ea_l = t_ea[l], ac_l = t_acum[l];
#pragma unroll
            for (int pt = 0; pt < 4; ++pt) { yacc[pt] = (f32x4){0.f, 0.f, 0.f, 0.f};
#pragma unroll
                for (int ks = 0; ks < 4; ++ks) yacc[pt] = __builtin_amdgcn_mfma_f32_16x16x32_bf16(frag_row(lds + HB, HBS, 16 * pt, 32 * ks, x, y), cf[ks], yacc[pt], 0, 0, 0);
                yacc[pt] = yacc[pt] * ea_l; }
#pragma unroll
            for (int ts = 0; ts < 8; ++ts) if (ts <= (lt | 1)) { const f32x4 as = *(const LAS f32x4*)(t_acum + 16 * ts + 4 * y), ds = *(const LAS f32x4*)(t_dt + 16 * ts + 4 * y); float gv[4];
#pragma unroll
                for (int e = 0; e < 4; ++e) { const int s = 16 * ts + 4 * y + e; const float ev = (s <= l) ? __expf(ac_l - as[e]) : 0.f; gv[e] = sacc[ts][e] * ev * ds[e]; }
                const int c = 32 * (ts >> 1) + 8 * y + 4 * (ts & 1);
                *(LAS v2u*)(lds + CS + l * CSS + c * 2) = (v2u){pk2(gv[0], gv[1]), pk2(gv[2], gv[3])}; }
            { const float cd = t_misc[0];
#pragma unroll
              for (int nt = 0; nt < 4; ++nt) hst[nt] = hst[nt] * cd;
#pragma unroll
              for (int ks = 0; ks < 4; ++ks) { const bf16x8 xf = frag_tr(lds + XW, XSS, 32 * ks, 16 * (w & 3), lane);
#pragma unroll
                  for (int nt = 0; nt < 4; ++nt) hst[nt] = __builtin_amdgcn_mfma_f32_16x16x32_bf16(frag_tr(lds + BS, BSS, 32 * ks, 16 * (4 * (w >> 2) + nt), lane), xf, hst[nt], 0, 0, 0); } }
#pragma unroll
            for (int ks = 0; ks < 4; ++ks) if (ks <= (lt >> 1)) { const bf16x8 gf = frag_row(lds + CS, CSS, 16 * lt, 32 * ks, x, y);
#pragma unroll
                for (int pt = 0; pt < 4; ++pt) yacc[pt] = __builtin_amdgcn_mfma_f32_16x16x32_bf16(frag_tr(lds + XS, XSS, 32 * ks, 16 * pt, lane), gf, yacc[pt], 0, 0, 0); }
            { const size_t m = m0 + l; float sq = 0.f;
#pragma unroll
              for (int pt = 0; pt < 4; ++pt) { const v2u xr = *(const LAS v2u*)(lds + XS + l * XSS + (16 * pt + 4 * y) * 2);
                  const float y0 = (yacc[pt].x + dsk * bflo(xr.x)) * silu_f(bflo(rz[pt].x)), y1 = (yacc[pt].y + dsk * bfhi(xr.x)) * silu_f(bfhi(rz[pt].x));
                  const float y2 = (yacc[pt].z + dsk * bflo(xr.y)) * silu_f(bflo(rz[pt].y)), y3 = (yacc[pt].w + dsk * bfhi(xr.y)) * silu_f(bfhi(rz[pt].y));
                  sq += (y0 * y0 + y1 * y1) + (y2 * y2 + y3 * y3);
                  *(v2u*)(YMIX + m * MIXW + hh * 64 + 16 * pt + 4 * y) = (v2u){pk2(y0, y1), pk2(y2, y3)}; }
              sq += __shfl_xor(sq, 16); sq += __shfl_xor(sq, 32);
              if (y == 0) SSQ[m * 16 + hh] = sq; }
            __syncthreads();
        }
#undef SSD_LOAD
    }
}

__device__ __forceinline__ void ssdnorm_phase(const Args& a, int G) {
    const int tid = threadIdx.x, rsub = tid >> 7, c8 = (tid & 127) * 8, g = c8 >> 9;
    bf16* YMIX = (bf16*)(a.ws + WS_YMIX); const float* SSQ = (const float*)(a.ws + WS_SSQ);
    float gsd[8];
#pragma unroll
    for (int e = 0; e < 8; ++e) gsd[e] = a.in[11][c8 + e];
    for (int r4 = blockIdx.x; r4 < M / 4; r4 += G) {
        const size_t m = (size_t)r4 * 4 + rsub;
        const f32x4 s0 = *(const f32x4*)(SSQ + m * 16 + g * 8), s1 = *(const f32x4*)(SSQ + m * 16 + g * 8 + 4);
        const float ss = ((s0.x + s0.y) + (s0.z + s0.w)) + ((s1.x + s1.y) + (s1.z + s1.w));
        const float rinv = 1.0f / sqrtf(ss * (1.0f / 512.0f) + EPS);
        float y[8]; v4u* pp = (v4u*)(YMIX + m * MIXW + 512 + c8); unpack8(*pp, y);
#pragma unroll
        for (int e = 0; e < 8; ++e) y[e] = y[e] * rinv * gsd[e];
        *pp = pack8(y);
    }
}

__device__ __forceinline__ void finalnorm_phase(const Args& a, int G) {
    const int tid = threadIdx.x, lane = tid & 63, wave = tid >> 6;
    const int gw = blockIdx.x * NWAVES + wave, NGW = G * NWAVES;
    f32x4 gf[4];
#pragma unroll
    for (int j = 0; j < 4; ++j) gf[j] = *(const f32x4*)(a.in[18] + 4 * lane + 256 * j);
    for (int m = gw; m < M; m += NGW) {
        f32x4* xr = (f32x4*)(a.out + (size_t)m * D) + lane;
        f32x4 v[4]; float ss = 0.f;
#pragma unroll
        for (int j = 0; j < 4; ++j) { v[j] = xr[64 * j]; ss += (v[j].x * v[j].x + v[j].y * v[j].y) + (v[j].z * v[j].z + v[j].w * v[j].w); }
        ss = wave_sum(ss);
        const float rinv = 1.0f / sqrtf(ss * (1.0f / D) + EPS);
#pragma unroll
        for (int j = 0; j < 4; ++j) xr[64 * j] = v[j] * rinv * gf[j];
    }
}

#define XB_TMO      128
#define XB_XCNT(j)  (256  + 64 * (j))
#define XB_XSUB(j)  (1280 + 64 * (j))
#define XB_XGEN(j)  (2304 + 64 * (j))
#define XB_TOP      3328
#define XB_TOPGEN   3392
#define XCD_BAR_WORDS 3456
#define XB_SPIN_CAP (1u << 18)

__device__ __forceinline__ unsigned xb_ld(unsigned* p)              { return __hip_atomic_load(p, __ATOMIC_RELAXED, __HIP_MEMORY_SCOPE_AGENT); }
__device__ __forceinline__ unsigned xb_add(unsigned* p, unsigned v) { return __hip_atomic_fetch_add(p, v, __ATOMIC_RELAXED, __HIP_MEMORY_SCOPE_AGENT); }
__device__ __forceinline__ unsigned xb_xcc_id() { return (unsigned)__builtin_amdgcn_s_getreg((3 << 11) | 20) & 0xFu; }
#define XB_SPIN(cond, bar) do { unsigned _sp = 0; while (cond) { __builtin_amdgcn_s_sleep(1); \
    if ((++_sp & 255u) == 0u) { if (xb_ld(&(bar)[XB_TMO])) break; if (_sp > XB_SPIN_CAP) { atomicAdd(&(bar)[XB_TMO], 1u); break; } } } } while (0)

struct XcdBarrier {
    unsigned* bar; unsigned x;
    volatile LAS unsigned* st;
};

__device__ __forceinline__ XcdBarrier xcd_barrier_post(unsigned* bar, volatile LAS unsigned* st) {
    XcdBarrier b; b.bar = bar; b.x = xb_xcc_id(); b.st = st;
    if (threadIdx.x == 0) (void)xb_add(&bar[XB_XCNT(b.x)], 1u);
    return b;
}
__device__ __forceinline__ void xcd_barrier_complete(unsigned* bar, unsigned x, unsigned& nloc, unsigned& nx) {
    const unsigned G = gridDim.x * gridDim.y * gridDim.z;
    unsigned sum, cnt, mine, sp = 0u;
    for (;;) {
        sum = 0u; cnt = 0u; mine = 0u;
#pragma unroll
        for (unsigned j = 0; j < 16; ++j) { const unsigned c = xb_ld(&bar[XB_XCNT(j)]); sum += c; cnt += (c > 0u) ? 1u : 0u; mine = (j == x) ? c : mine; }
        if (sum == G) break;
        __builtin_amdgcn_s_sleep(1);
        if ((++sp & 255u) == 0u) { if (xb_ld(&bar[XB_TMO])) break; if (sp > XB_SPIN_CAP) { atomicAdd(&bar[XB_TMO], 1u); break; } }
    }
    nloc = mine > 0u ? mine : 1u; nx = cnt > 0u ? cnt : 1u;
}

__device__ __forceinline__ void xcd_barrier(const XcdBarrier& b) {
    asm volatile("s_waitcnt vmcnt(0)" ::: "memory");
    __syncthreads();
    if (threadIdx.x == 0) {
        unsigned* bar = b.bar;
        __builtin_amdgcn_s_waitcnt(0);
        unsigned nloc = b.st[0], nx = b.st[1];
        if (nloc == 0u) { xcd_barrier_complete(bar, b.x, nloc, nx); b.st[0] = nloc; b.st[1] = nx; }
        const unsigned old = xb_add(&bar[XB_XSUB(b.x)], 1u);
        const unsigned gen = old / nloc;
        if (old + 1u == (gen + 1u) * nloc) {
            __builtin_amdgcn_fence(__ATOMIC_RELEASE, "agent");
            asm volatile("s_waitcnt vmcnt(0)" ::: "memory");
            const unsigned og = xb_add(&bar[XB_TOP], 1u);
            const unsigned tg = og / nx;
            if (og + 1u == (tg + 1u) * nx) xb_add(&bar[XB_TOPGEN], 1u);
            else XB_SPIN(xb_ld(&bar[XB_TOPGEN]) == tg, bar);
            __builtin_amdgcn_fence(__ATOMIC_ACQUIRE, "agent");
            xb_add(&bar[XB_XGEN(b.x)], 1u);
            asm volatile("s_waitcnt vmcnt(0)" ::: "memory");
        } else {
            XB_SPIN(xb_ld(&bar[XB_XGEN(b.x)]) == gen, bar);
            __builtin_amdgcn_fence(__ATOMIC_ACQUIRE, "agent");
            asm volatile("s_waitcnt vmcnt(0)" ::: "memory");
        }
    }
    __syncthreads();
}

constexpr int NPHASES = 11;
__global__ void __launch_bounds__(NTHR, 2) fwd_kernel(Args args) {
    extern __shared__ __attribute__((aligned(16))) unsigned char lds_raw[];
    LAS unsigned char* lds = (LAS unsigned char*)lds_raw;
    cg::grid_group grid = cg::this_grid();
    const int G = gridDim.x, lo = args.ph_lo, hi = args.ph_hi;
    unsigned char* ws = args.ws;
    float* MOD = (float*)(ws + WS_MOD);
#ifndef PH_MASK
#define PH_MASK 0x7ff
#endif
    constexpr int MISC_OFF = 135168;
    unsigned* barw = (unsigned*)(ws + WS_BAR);
    if (threadIdx.x < 2) ((volatile LAS unsigned*)(lds + MISC_OFF))[threadIdx.x] = 0u;
    if (blockIdx.x == 0) for (int i = threadIdx.x; i < XCD_BAR_WORDS; i += NTHR) __hip_atomic_store(barw + i, 0u, __ATOMIC_RELAXED, __HIP_MEMORY_SCOPE_AGENT);
    __syncthreads();
    XcdBarrier xbar; xbar.bar = barw; xbar.x = 0; xbar.st = (volatile LAS unsigned*)(lds + MISC_OFF);
#define IN(k) ((((PH_MASK) >> (k)) & 1) && lo <= (k) && (k) < hi)
#ifndef PROBE_DUP
#define PROBE_DUP -1
#endif
#define PH(k, ...) do { if (IN(k)) { __VA_ARGS__ if (PROBE_DUP == (k)) { if ((k) == 0) grid.sync(); else xcd_barrier(xbar); __VA_ARGS__ } } } while (0);
#define SEAM67() do { if (IN(6) && IN(8)) xcd_barrier(xbar); } while (0)
#define SEAMX(a_, b_) do { if (IN(a_) && IN(b_)) xcd_barrier(xbar); } while (0)
#define SEAM(k) do { if (IN(k) && IN((k) + 1)) xcd_barrier(xbar); } while (0)
    PH(0, { p0_prologue(lds, args, G); })
    if (IN(0) && IN(1)) { grid.sync(); xbar = xcd_barrier_post(barw, (volatile LAS unsigned*)(lds + MISC_OFF)); }
#ifdef PROBE_SYNCS
    for (int i_ = 0; i_ < PROBE_SYNCS; ++i_) xcd_barrier(xbar);
#endif
    PH(1, { small_proj<false>(lds, MOD + 3072, NMOD, args.in[16], FF, FF, nullptr, (float*)(ws + WS_SHW), FF, G); normmod_phase<true>(lds, args.in[0], args.in[4], MOD, 0, 1024, (bf16*)(ws + WS_XN), args.in[5], args.in[8], (float*)(ws + WS_DT), G); __syncthreads(); }) SEAM(1);
    PH(2, { pg8::Gemm g{(const bf16*)(ws + WS_XN), (const bf16*)(ws + WS_WIN), M, NPROJ, D}; pg8::StaticOrder S; S.init(M, NPROJ, G, (int)blockIdx.x);
        pg8::EpiBf16<0> E{(bf16*)(ws + WS_PROJ), NPROJ}; pg8::gemm_phase<pg8::EpiBf16<0>, pg8::StaticOrder, true, true>(lds, g, S, E); }) SEAM(2);
    PH(3, { halo_phase(args, G); }) SEAM(3);
    #ifdef SSD_NAIVE
    PH(4, { ssd_naive_phase(lds, args, G); }) SEAMX(4, 6);
#else
    PH(4, { ssd_chunk_phase(lds, args, G); }) SEAMX(4, 6);
#endif
    PH(6, { pg8::Gemm g{(const bf16*)(ws + WS_YMIX), (const bf16*)(ws + WS_WOUT), M, D, MIXW}; pg8::SsdOrder S; S.init(M, D, G, (int)blockIdx.x); S.ssq = (const float*)(ws + WS_SSQ); S.lds = lds; S.eps = EPS;
        pg8::EpiResGate2 E{args.in[0], args.out, MOD + 2048, args.in[15], MOD + 4096, (bf16*)(ws + WS_XN), (float*)(ws + WS_ROWP), SEQ, NMOD}; pg8::gemm_phase<pg8::EpiResGate2, pg8::SsdOrder, true, true>(lds, g, S, E); }) SEAM67();
    PH(8, { pg8::Gemm g{(const bf16*)(ws + WS_XN), (const bf16*)(ws + WS_WUP), M, FF, D}; pg8::StaticOrder S; S.init(M, FF, G, (int)blockIdx.x);
        pg8::EpiUp E{(bf16*)(ws + WS_F), FF, (const float*)(ws + WS_ROWP), (const float*)(ws + WS_SHW), SEQ, 1.0f / D, EPS}; pg8::gemm_phase<pg8::EpiUp, pg8::StaticOrder, true, true>(lds, g, S, E); }) SEAM(8);
    PH(9, { pg8::Gemm g{(const bf16*)(ws + WS_F), (const bf16*)(ws + WS_WDN), M, D, FF}; pg8::StaticOrder S; S.init(M, D, G, (int)blockIdx.x);
        pg8::EpiResGate E{args.out, args.out, MOD + 5120, SEQ, NMOD}; pg8::gemm_phase<pg8::EpiResGate, pg8::StaticOrder, true, true>(lds, g, S, E); }) SEAM(9);
    PH(10, { finalnorm_phase(args, G); })
#undef IN
#undef SEAM
}

#ifndef MK_ONE_LAUNCH
#define MK_ONE_LAUNCH 1
#endif
extern "C" void kernel_launch(void* const* d_in, const int* in_sizes, int n_in, void* d_out, int out_size, void* d_ws, size_t ws_size, hipStream_t stream) {
    static int grid = 0;
    if (grid == 0) {
        if (n_in != 19 || out_size != M * D || ws_size < WS_END) { fprintf(stderr, "kernel_launch: unexpected shapes (n_in %d, out %d, ws %zu)\n", n_in, out_size, ws_size); grid = -1; return; }
        int dev = 0, cus = 0, per_cu = 0;
        if (hipGetDevice(&dev) != hipSuccess || hipDeviceGetAttribute(&cus, hipDeviceAttributeMultiprocessorCount, dev) != hipSuccess) { grid = -1; return; }
        if (hipFuncSetAttribute((const void*)fwd_kernel, hipFuncAttributeMaxDynamicSharedMemorySize, LDS_BYTES) != hipSuccess) { fprintf(stderr, "kernel_launch: hipFuncSetAttribute failed\n"); grid = -1; return; }
        if (hipOccupancyMaxActiveBlocksPerMultiprocessor(&per_cu, (const void*)fwd_kernel, NTHR, LDS_BYTES) != hipSuccess || per_cu < 1) { fprintf(stderr, "kernel_launch: occupancy query says %d\n", per_cu); (void)hipGetLastError(); per_cu = 1; }
        grid = cus * per_cu;
        fprintf(stderr, "kernel_launch: grid %d (cus %d x %d)\n", grid, cus, per_cu);
    }
    if (grid < 0) return;
    Args a{};
    for (int i = 0; i < 19; ++i) a.in[i] = (const float*)d_in[i];
    a.out = (float*)d_out; a.ws = (unsigned char*)d_ws;
#if MK_ONE_LAUNCH
    a.ph_lo = 0; a.ph_hi = NPHASES;
    void* kargs[] = {&a};
    hipError_t e = hipLaunchCooperativeKernel((const void*)fwd_kernel, dim3(grid), dim3(NTHR), kargs, LDS_BYTES, stream);
    if (e != hipSuccess) fprintf(stderr, "kernel_launch: cooperative launch failed: %s (grid %d)\n", hipGetErrorString(e), grid);
#else
    for (int ph = 0; ph < NPHASES; ++ph) {
        a.ph_lo = ph; a.ph_hi = ph + 1;
        hipLaunchKernelGGL(fwd_kernel, dim3(grid), dim3(NTHR), LDS_BYTES, stream, a);
    }
#endif
}
```

```cpp
#include <hip/hip_runtime.h>
#include <hip/hip_cooperative_groups.h>
#include <cstdio>
#include <cstdint>
namespace cg = cooperative_groups;
namespace pg8 {
#define PG8_LAS __attribute__((address_space(3)))
typedef unsigned short bf16_t;
typedef short bf16x8 __attribute__((ext_vector_type(8)));
typedef float f32x4 __attribute__((ext_vector_type(4)));
typedef unsigned u32x4 __attribute__((ext_vector_type(4)));
constexpr int BM = 256, BK = 64, HALF = 128, HTB = HALF * BK * 2  , STAGE_BYTES = 8 * HTB, NXCD = 8, WGM = 8;

__host__ __device__ __forceinline__ int lds_byte(int r, int c) { const int st = (r >> 4) * 2 + (c >> 5), rr = r & 15, cc = c & 31, ob = rr * 64 + cc * 2; return st * 1024 + (ob ^ (((ob >> 9) & 1) << 5)); }
__host__ __device__ __forceinline__ void stage_rc(int b, int& R, int& C) { const int st = b / 1024, sb = b % 1024, swz = sb ^ (((sb >> 9) & 1) << 5); R = (st >> 1) * 16 + swz / 64; C = (st & 1) * 32 + (swz % 64) / 2; }
__host__ __device__ __forceinline__ int perm32(int rho) { const int n = rho >> 4, i = rho & 15; return 8 * (i >> 2) + 4 * n + (i & 3); }

struct Unit { int pm, pn; };
struct Gemm { const bf16_t* A; const bf16_t* Bt; int M, N, K; };

struct StaticOrder {
    int nM, nN, nwg, G, c;
    __host__ __device__ void init(int M, int N, int G_, int c_) { nM = M / BM; nN = N / BM; nwg = nM * nN; G = G_; c = c_; }
    __host__ __device__ bool next(int i, Unit& u) const {
        const long L = (long)i * G + c; if (L >= nwg) return false;
        int wgid = (int)L; { const int q = nwg / NXCD, r = nwg % NXCD, xcd = wgid % NXCD, off = wgid / NXCD; wgid = (xcd < r ? xcd * (q + 1) : r * (q + 1) + (xcd - r) * q) + off; }
        const int nig = WGM * nN, gid = wgid / nig, fm = gid * WGM, gsz = (nM - fm) < WGM ? (nM - fm) : WGM;
        u.pm = fm + ((wgid % nig) % gsz); u.pn = (wgid % nig) / gsz; return true;
    }
    __device__ __forceinline__ void a_ready(const Unit&) const {}
    __device__ __forceinline__ void done(const Unit&) const {}
};

struct SsdOrder : StaticOrder {
    const float* ssq; PG8_LAS unsigned char* lds; float eps;
    __device__ __forceinline__ void a_ready(const Unit& u) const {
        const int tid = threadIdx.x;
        if (tid < 256) { const f32x4* sp = (const f32x4*)(ssq + (size_t)(u.pm * BM + tid) * 16); const f32x4 a0 = sp[0], a1 = sp[1], b0 = sp[2], b1 = sp[3];
            const float s0 = ((a0[0] + a0[1]) + (a0[2] + a0[3])) + ((a1[0] + a1[1]) + (a1[2] + a1[3])), s1 = ((b0[0] + b0[1]) + (b0[2] + b0[3])) + ((b1[0] + b1[1]) + (b1[2] + b1[3]));
            const float r0 = 1.0f / sqrtf(s0 * (1.0f / 512.0f) + eps), r1 = 1.0f / sqrtf(s1 * (1.0f / 512.0f) + eps);
            PG8_LAS float* tab = (PG8_LAS float*)(lds + STAGE_BYTES); tab[tid * 2] = r0 / r1; tab[tid * 2 + 1] = r1; }
    }
};

__device__ __forceinline__ unsigned cvt_pk_bf16(float lo, float hi) { unsigned r; asm volatile("v_cvt_pk_bf16_f32 %0, %1, %2" : "=v"(r) : "v"(lo), "v"(hi)); return r; }
typedef float f32x2 __attribute__((ext_vector_type(2)));
template <int ACT  > struct EpiBf16 {
    static constexpr bool PERM = true, AFTER_DRAIN = false, KSCALE = false;
    bf16_t* O; int ldc;
    __device__ __forceinline__ void operator()(const f32x4 (&acc)[2][2][4][2], const Unit& u, int wr, int wc, int fr, int fq) const {
        const int row0 = u.pm * BM + wr * 64 + fr; const int col0 = u.pn * BM + wc * 32 + 8 * fq;
#pragma unroll
        for (int ai = 0; ai < 2; ++ai)
#pragma unroll
            for (int m = 0; m < 4; ++m) { bf16_t* rowp = O + (size_t)(row0 + ai * HALF + m * 16) * ldc + col0;
#pragma unroll
                for (int bj = 0; bj < 2; ++bj) { f32x4 v0 = acc[ai][bj][m][0], v1 = acc[ai][bj][m][1];
                    if (ACT == 2) {
#pragma unroll
                        for (int j = 0; j < 4; ++j) { const float a = fmaxf(v0[j], 0.f), b = fmaxf(v1[j], 0.f); v0[j] = a * a; v1[j] = b * b; } }
                    u32x4 w; w.x = cvt_pk_bf16(v0[0], v0[1]); w.y = cvt_pk_bf16(v0[2], v0[3]); w.z = cvt_pk_bf16(v1[0], v1[1]); w.w = cvt_pk_bf16(v1[2], v1[3]);
                    *(u32x4*)(rowp + bj * HALF) = w; } }
    }
};
struct EpiResGate {
    static constexpr bool PERM = false, AFTER_DRAIN = false, KSCALE = false;
    const float* base; float* out; const float* gate; int rows_per_batch, gate_stride;
    __device__ __forceinline__ void operator()(const f32x4 (&acc)[2][2][4][2], const Unit& u, int wr, int wc, int fr, int fq) const {
        const int row0 = u.pm * BM + wr * 64 + fr, col0 = u.pn * BM + wc * 32 + 4 * fq;
        const float* gp = gate + (size_t)((u.pm * BM) / rows_per_batch) * gate_stride + col0;
        f32x4 gv[2][2];
#pragma unroll
        for (int bj = 0; bj < 2; ++bj)
#pragma unroll
            for (int n = 0; n < 2; ++n) gv[bj][n] = *(const f32x4*)(gp + bj * HALF + n * 16);
#pragma unroll
        for (int ai = 0; ai < 2; ++ai)
#pragma unroll
            for (int m = 0; m < 4; ++m) { const size_t off = (size_t)(row0 + ai * HALF + m * 16) * 1024 + col0;
#pragma unroll
                for (int bj = 0; bj < 2; ++bj)
#pragma unroll
                    for (int n = 0; n < 2; ++n) { const f32x4 bs = *(const f32x4*)(base + off + bj * HALF + n * 16); *(f32x4*)(out + off + bj * HALF + n * 16) = bs + gv[bj][n] * acc[ai][bj][m][n]; }
                asm volatile("" ::: "memory"); }
    }
};
struct EpiResGate2 {
    static constexpr bool PERM = false, AFTER_DRAIN = false, KSCALE = true; static constexpr int KS_T0 = 6, KS_T1 = 14;
    __device__ __forceinline__ void kscale(f32x4 (&acc)[2][2][4][2], PG8_LAS unsigned char* lds, int which, int wr, int fr) const {
        const PG8_LAS float* tab = (const PG8_LAS float*)(lds + STAGE_BYTES);
#pragma unroll
        for (int ai = 0; ai < 2; ++ai)
#pragma unroll
            for (int m = 0; m < 4; ++m) { const float f = tab[(ai * HALF + wr * 64 + m * 16 + fr) * 2 + which];
#pragma unroll
                for (int bj = 0; bj < 2; ++bj)
#pragma unroll
                    for (int n = 0; n < 2; ++n) acc[ai][bj][m][n] = acc[ai][bj][m][n] * f; }
    }
    const float* base; float* out; const float* gate; const float* gvec; const float* scale; bf16_t* xn; float* rowp; int rows_per_batch, gate_stride;
    __device__ __forceinline__ void operator()(const f32x4 (&acc)[2][2][4][2], const Unit& u, int wr, int wc, int fr, int fq) const {
        const int row0 = u.pm * BM + wr * 64 + fr, col0 = u.pn * BM + wc * 32 + 4 * fq;
        const size_t bofs = (size_t)((u.pm * BM) / rows_per_batch) * gate_stride + col0;
        f32x4 gv[2][2], gs[2][2];
#pragma unroll
        for (int bj = 0; bj < 2; ++bj)
#pragma unroll
            for (int n = 0; n < 2; ++n) { gv[bj][n] = *(const f32x4*)(gate + bofs + bj * HALF + n * 16);
                gs[bj][n] = *(const f32x4*)(gvec + col0 + bj * HALF + n * 16) * (*(const f32x4*)(scale + bofs + bj * HALF + n * 16) + 1.0f); }
#pragma unroll
        for (int ai = 0; ai < 2; ++ai)
#pragma unroll
            for (int m = 0; m < 4; ++m) { const int row = row0 + ai * HALF + m * 16; const size_t off = (size_t)row * 1024 + col0; float ss = 0.f;
#pragma unroll
                for (int bj = 0; bj < 2; ++bj)
#pragma unroll
                    for (int n = 0; n < 2; ++n) { const f32x4 bs = *(const f32x4*)(base + off + bj * HALF + n * 16); const f32x4 h = bs + gv[bj][n] * acc[ai][bj][m][n];
                        *(f32x4*)(out + off + bj * HALF + n * 16) = h; ss += (h[0] * h[0] + h[1] * h[1]) + (h[2] * h[2] + h[3] * h[3]);
                        const f32x4 av = h * gs[bj][n]; typedef unsigned u32x2v __attribute__((ext_vector_type(2))); u32x2v wv; wv.x = cvt_pk_bf16(av[0], av[1]); wv.y = cvt_pk_bf16(av[2], av[3]);
                        *(u32x2v*)(xn + off + bj * HALF + n * 16) = wv; }
                ss += __shfl_xor(ss, 16); ss += __shfl_xor(ss, 32);
                if (fq == 0) rowp[(size_t)row * 16 + u.pn * 4 + wc] = ss;
                asm volatile("" ::: "memory"); }
    }
};
struct EpiUp {
    static constexpr bool PERM = true, AFTER_DRAIN = false, KSCALE = false;
    bf16_t* O; int ldc; const float* rowp; const float* shw; int rows_per_batch; float inv_d, eps;
    __device__ __forceinline__ void operator()(const f32x4 (&acc)[2][2][4][2], const Unit& u, int wr, int wc, int fr, int fq) const {
        const int row0 = u.pm * BM + wr * 64 + fr; const int col0 = u.pn * BM + wc * 32 + 8 * fq;
        const float* sp = shw + (size_t)((u.pm * BM) / rows_per_batch) * ldc + col0;
        f32x4 bv[2][2];
#pragma unroll
        for (int bj = 0; bj < 2; ++bj)
#pragma unroll
            for (int n = 0; n < 2; ++n) bv[bj][n] = *(const f32x4*)(sp + bj * HALF + 4 * n);
#pragma unroll
        for (int ai = 0; ai < 2; ++ai)
#pragma unroll
            for (int m = 0; m < 4; ++m) { const int row = row0 + ai * HALF + m * 16; bf16_t* rowp_o = O + (size_t)row * ldc + col0;
                const f32x4* rp = (const f32x4*)(rowp + (size_t)row * 16); const f32x4 p0 = rp[0], p1 = rp[1], p2 = rp[2], p3 = rp[3];
                const float ss = (((p0[0] + p0[1]) + (p0[2] + p0[3])) + ((p1[0] + p1[1]) + (p1[2] + p1[3]))) + (((p2[0] + p2[1]) + (p2[2] + p2[3])) + ((p3[0] + p3[1]) + (p3[2] + p3[3])));
                const float rinv = 1.0f / sqrtf(ss * inv_d + eps);
#pragma unroll
                for (int bj = 0; bj < 2; ++bj) { f32x4 v0 = acc[ai][bj][m][0] * rinv + bv[bj][0], v1 = acc[ai][bj][m][1] * rinv + bv[bj][1];
#pragma unroll
                    for (int j = 0; j < 4; ++j) { const float a = fmaxf(v0[j], 0.f), b = fmaxf(v1[j], 0.f); v0[j] = a * a; v1[j] = b * b; }
                    u32x4 w; w.x = cvt_pk_bf16(v0[0], v0[1]); w.y = cvt_pk_bf16(v0[2], v0[3]); w.z = cvt_pk_bf16(v1[0], v1[1]); w.w = cvt_pk_bf16(v1[2], v1[3]);
                    *(u32x4*)(rowp_o + bj * HALF) = w; } }
    }
};
template <class Epi, class Sched, bool ALIGN_EPI = false, bool SP2 = false>
__device__ __forceinline__ void gemm_phase(PG8_LAS unsigned char* lds, const Gemm g, const Sched& S, const Epi& E) {
    const int tid = threadIdx.x, wid = __builtin_amdgcn_readfirstlane(tid >> 6), lane = tid & 63, wr = wid >> 2, wc = wid & 3, fr = lane & 15, fq = lane >> 4;
    const int K = g.K, nt = K / BK;
    unsigned voffA[2], voffB[2];
#pragma unroll
    for (int i = 0; i < 2; ++i) { int R, C; stage_rc(tid * 16 + i * 8192, R, C); const int Rb = Epi::PERM ? ((R & ~31) + perm32(R & 31)) : R;
        voffA[i] = (unsigned)(R * K + C) * 2u; voffB[i] = (unsigned)(Rb * K + C) * 2u; }
    const size_t kstep = (size_t)(BK * 2);
    const size_t hstep = (size_t)HALF * K * 2;
    const size_t tstep = 2 * hstep;
    const unsigned ldsw = (unsigned)wid * 1024u;
    const int aoff = lds_byte(wr * 64 + fr, fq * 8), boff = lds_byte(wc * 32 + fr, fq * 8);
#define PG8_SA(b, h) (((b) * 2 + (h)) * HTB)
#define PG8_SB(b, h) ((4 + (b) * 2 + (h)) * HTB)
#define PG8_STAGE(bufoff, gbase, voff) do { _Pragma("unroll") for (int _i = 0; _i < 2; ++_i) \
        __builtin_amdgcn_global_load_lds((const unsigned*)((const char*)(gbase) + (voff)[_i]), (PG8_LAS unsigned*)(lds + (bufoff) + ldsw + _i * 8192), 16, 0, 0); } while (0)
#define PG8_LDA(dst, b, h) do { _Pragma("unroll") for (int m = 0; m < 4; ++m) _Pragma("unroll") for (int k = 0; k < 2; ++k) dst[m][k] = *(const PG8_LAS bf16x8*)(lds + PG8_SA(b, h) + aoff + m * 2048 + k * 1024); } while (0)
#define PG8_LDB(dst, b, h) do { _Pragma("unroll") for (int n = 0; n < 2; ++n) _Pragma("unroll") for (int k = 0; k < 2; ++k) dst[n][k] = *(const PG8_LAS bf16x8*)(lds + PG8_SB(b, h) + boff + n * 2048 + k * 1024); } while (0)
#define PG8_MMA(ai, bj, At, Bt) do { __builtin_amdgcn_s_setprio(1); _Pragma("unroll") for (int m = 0; m < 4; ++m) _Pragma("unroll") for (int n = 0; n < 2; ++n) _Pragma("unroll") for (int k = 0; k < 2; ++k) \
        acc[ai][bj][m][n] = __builtin_amdgcn_mfma_f32_16x16x32_bf16(Bt[n][k], At[m][k], acc[ai][bj][m][n], 0, 0, 0); __builtin_amdgcn_s_setprio(0); } while (0)
#define PG8_WAIT_V(n) asm volatile("s_waitcnt vmcnt(" #n ")" ::: "memory")
#define PG8_WAIT_L(n) asm volatile("s_waitcnt lgkmcnt(" #n ")" ::: "memory")
#define PG8_BAR __builtin_amdgcn_s_barrier()
#define PG8_SCHED __builtin_amdgcn_sched_barrier(0)
    Unit cur, nxt; int ui = 0;
    if (!S.next(0, cur)) return;
    f32x4 acc[2][2][4][2];
#pragma unroll
    for (int a = 0; a < 2; ++a)
#pragma unroll
        for (int b = 0; b < 2; ++b)
#pragma unroll
            for (int m = 0; m < 4; ++m)
#pragma unroll
                for (int n = 0; n < 2; ++n) acc[a][b][m][n] = (f32x4){0.f, 0.f, 0.f, 0.f};
    bf16x8 At[4][2], B0[2][2], B1[2][2];
    const char* cA = (const char*)g.A + (size_t)cur.pm * tstep; const char* cB = (const char*)g.Bt + (size_t)cur.pn * tstep;
    S.a_ready(cur);
    if constexpr (SP2) {
        PG8_STAGE(PG8_SB(0, 0), cB, voffB); PG8_STAGE(PG8_SB(0, 1), cB + hstep, voffB); PG8_STAGE(PG8_SA(0, 0), cA, voffA); PG8_STAGE(PG8_SA(0, 1), cA + hstep, voffA);
        if (wr == 1) PG8_BAR;
        PG8_WAIT_V(2); PG8_BAR;
        PG8_STAGE(PG8_SB(1, 0), cB + kstep, voffB); PG8_STAGE(PG8_SA(1, 0), cA + kstep, voffA); PG8_STAGE(PG8_SB(1, 1), cB + hstep + kstep, voffB);
        PG8_WAIT_V(6); PG8_BAR;
    } else {
        PG8_STAGE(PG8_SB(0, 0), cB, voffB); PG8_STAGE(PG8_SA(0, 0), cA, voffA); PG8_STAGE(PG8_SB(0, 1), cB + hstep, voffB); PG8_STAGE(PG8_SA(0, 1), cA + hstep, voffA);
        if (wr == 1) PG8_BAR;
        PG8_WAIT_V(4); PG8_BAR;
        PG8_STAGE(PG8_SB(1, 0), cB + kstep, voffB); PG8_STAGE(PG8_SA(1, 0), cA + kstep, voffA); PG8_STAGE(PG8_SB(1, 1), cB + hstep + kstep, voffB);
        PG8_WAIT_V(6); PG8_BAR;
    }
    for (;;) {
        const bool has_next = S.next(ui + 1, nxt);
        const char* nA = has_next ? (const char*)g.A + (size_t)nxt.pm * tstep : cA; const char* nB = has_next ? (const char*)g.Bt + (size_t)nxt.pn * tstep : cB;
        for (int t = 0; t < nt; t += 2) {
            const bool last = (t == nt - 2);
            const char* a1 = cA + (size_t)(t + 1) * kstep;
            const char* a2 = last ? nA : cA + (size_t)(t + 2) * kstep; const char* b2 = last ? nB : cB + (size_t)(t + 2) * kstep;
            const char* a3 = a2 + kstep; const char* b3 = b2 + kstep;
            if (last && has_next) S.a_ready(nxt);
            if constexpr (SP2) {
            PG8_LDB(B0, 0, 0); PG8_LDB(B1, 0, 1); PG8_SCHED; PG8_LDA(At, 0, 0); PG8_STAGE(PG8_SA(1, 1), a1 + hstep, voffA);
            PG8_WAIT_V(8); PG8_WAIT_L(0); PG8_BAR; PG8_MMA(0, 0, At, B0); PG8_MMA(0, 1, At, B1); PG8_BAR; PG8_SCHED;
            PG8_LDA(At, 0, 1); PG8_STAGE(PG8_SB(0, 0), b2, voffB); PG8_STAGE(PG8_SB(0, 1), b2 + hstep, voffB); PG8_STAGE(PG8_SA(0, 0), a2, voffA);
            PG8_WAIT_V(8); PG8_WAIT_L(0); PG8_BAR; PG8_MMA(1, 0, At, B0); PG8_MMA(1, 1, At, B1); PG8_BAR; PG8_SCHED;
            PG8_LDB(B0, 1, 0); PG8_LDB(B1, 1, 1); PG8_SCHED; PG8_LDA(At, 1, 0); PG8_STAGE(PG8_SA(0, 1), a2 + hstep, voffA);
            PG8_WAIT_V(8); PG8_WAIT_L(0); PG8_BAR; PG8_MMA(0, 0, At, B0); PG8_MMA(0, 1, At, B1); PG8_BAR; PG8_SCHED;
            PG8_LDA(At, 1, 1); PG8_STAGE(PG8_SB(1, 0), b3, voffB); PG8_STAGE(PG8_SB(1, 1), b3 + hstep, voffB); PG8_STAGE(PG8_SA(1, 0), a3, voffA);
            PG8_WAIT_V(8); PG8_WAIT_L(0); PG8_BAR; PG8_MMA(1, 0, At, B0); PG8_MMA(1, 1, At, B1); PG8_BAR; PG8_SCHED;
            if constexpr (Epi::KSCALE) { if (t == Epi::KS_T0 || t == Epi::KS_T1) { E.kscale(acc, lds, t == Epi::KS_T1 ? 1 : 0, wr, fr); PG8_SCHED; } }
            } else {
            PG8_LDB(B0, 0, 0); PG8_SCHED; PG8_LDA(At, 0, 0); PG8_STAGE(PG8_SA(1, 1), a1 + hstep, voffA);
            PG8_WAIT_L(8); PG8_BAR; PG8_WAIT_L(0); PG8_MMA(0, 0, At, B0); PG8_BAR; PG8_SCHED;
            PG8_LDB(B1, 0, 1); PG8_STAGE(PG8_SB(0, 0), b2, voffB);
            PG8_BAR; PG8_WAIT_L(0); PG8_MMA(0, 1, At, B1); PG8_BAR;
            PG8_LDA(At, 0, 1); PG8_STAGE(PG8_SA(0, 0), a2, voffA);
            PG8_BAR; PG8_WAIT_L(0); PG8_MMA(1, 0, At, B0); PG8_BAR; PG8_SCHED;
            PG8_STAGE(PG8_SB(0, 1), b2 + hstep, voffB);
            PG8_WAIT_V(6); PG8_BAR; PG8_MMA(1, 1, At, B1); PG8_BAR;
            PG8_LDB(B0, 1, 0); PG8_SCHED; PG8_LDA(At, 1, 0); PG8_STAGE(PG8_SA(0, 1), a2 + hstep, voffA);
            PG8_WAIT_L(8); PG8_BAR; PG8_WAIT_L(0); PG8_MMA(0, 0, At, B0); PG8_BAR; PG8_SCHED;
            PG8_LDB(B1, 1, 1); PG8_STAGE(PG8_SB(1, 0), b3, voffB);
            PG8_BAR; PG8_WAIT_L(0); PG8_MMA(0, 1, At, B1); PG8_BAR;
            PG8_LDA(At, 1, 1); PG8_STAGE(PG8_SA(1, 0), a3, voffA);
            PG8_BAR; PG8_WAIT_L(0); PG8_MMA(1, 0, At, B0); PG8_BAR; PG8_SCHED;
            PG8_STAGE(PG8_SB(1, 1), b3 + hstep, voffB);
            PG8_WAIT_V(6); PG8_BAR; PG8_MMA(1, 1, At, B1); PG8_BAR;
            }
        }
        if constexpr (ALIGN_EPI) { if (wr == 0) PG8_BAR; }
        if constexpr (!Epi::AFTER_DRAIN) { E(acc, cur, wr, wc, fr, fq); S.done(cur); }
        if (!has_next) break;
#pragma unroll
        for (int a = 0; a < 2; ++a)
#pragma unroll
            for (int b = 0; b < 2; ++b)
#pragma unroll
                for (int m = 0; m < 4; ++m)
#pragma unroll
                    for (int n = 0; n < 2; ++n) acc[a][b][m][n] = (f32x4){0.f, 0.f, 0.f, 0.f};
        cur = nxt; cA = nA; cB = nB; ++ui;
        if constexpr (ALIGN_EPI) { if (wr == 1) PG8_BAR; }
    }
    PG8_WAIT_V(0);
    if constexpr (!ALIGN_EPI) { if (wr == 0) PG8_BAR; }
    PG8_BAR;
    if constexpr (Epi::AFTER_DRAIN) { E.fused(acc, cur, wr, wc, fr, fq, lds, wid, lane); S.done(cur); }
#undef PG8_SA
#undef PG8_SB
#undef PG8_STAGE
#undef PG8_LDA
#undef PG8_LDB
#undef PG8_MMA
#undef PG8_WAIT_V
#undef PG8_WAIT_L
#undef PG8_BAR
#undef PG8_SCHED
}
}
#define LAS __attribute__((address_space(3)))
typedef unsigned short bf16;
typedef unsigned v4u __attribute__((ext_vector_type(4)));
typedef unsigned v2u __attribute__((ext_vector_type(2)));
typedef float f32x4 __attribute__((ext_vector_type(4)));
constexpr int D = 1024, BATCH = 16, SEQ = 2048, M = BATCH * SEQ;
constexpr int NHEADS = 16, HD = 64, NST = 128, CONVCH = 1536, MIXW = 1536, INW = 3088, NPROJ = 3072, FF = 4096, NMOD = 6 * D;
constexpr float EPS = 1e-5f;
constexpr int NWAVES = 8, NTHR = 512;
constexpr int LDS_BYTES = 147456;
constexpr size_t MiB = 1u << 20;
constexpr size_t WS_MOD = 0, WS_BAR = 512 * 1024, WS_SHW = 1 * MiB, WS_ROWP = 480 * MiB, WS_DT = 2 * MiB, WS_SSQ = 4 * MiB, WS_WIN = 6 * MiB, WS_WOUT = 12 * MiB, WS_WUP = 16 * MiB, WS_WDN = 24 * MiB;
constexpr size_t WS_XN = 32 * MiB, WS_PROJ = 96 * MiB, WS_CONV = 288 * MiB, WS_YMIX = 384 * MiB, WS_F = 96 * MiB, WS_END = 482 * MiB;

__device__ __forceinline__ unsigned f2bf(float f) { unsigned u = __float_as_uint(f); return (u + 0x7fffu + ((u >> 16) & 1u)) >> 16; }
__device__ __forceinline__ unsigned pk2(float lo, float hi) { unsigned r; asm("v_cvt_pk_bf16_f32 %0, %1, %2" : "=v"(r) : "v"(lo), "v"(hi)); return r; }
__device__ __forceinline__ float bflo(unsigned w) { return __uint_as_float(w << 16); }
__device__ __forceinline__ float bfhi(unsigned w) { return __uint_as_float(w & 0xffff0000u); }
__device__ __forceinline__ void unpack8(const v4u w, float (&f)[8]) { f[0] = bflo(w.x); f[1] = bfhi(w.x); f[2] = bflo(w.y); f[3] = bfhi(w.y); f[4] = bflo(w.z); f[5] = bfhi(w.z); f[6] = bflo(w.w); f[7] = bfhi(w.w); }
__device__ __forceinline__ v4u pack8(const float (&f)[8]) { v4u w; w.x = pk2(f[0], f[1]); w.y = pk2(f[2], f[3]); w.z = pk2(f[4], f[5]); w.w = pk2(f[6], f[7]); return w; }
__device__ __forceinline__ float wave_sum(float v) {
#pragma unroll
    for (int o = 1; o < 64; o <<= 1) v += __shfl_xor(v, o);
    return v;
}
__device__ __forceinline__ float silu_f(float v) { return v * __builtin_amdgcn_rcpf(1.f + __builtin_amdgcn_exp2f(-1.44269504f * v)); }
__device__ __forceinline__ float softplus_f(float v) { return fmaxf(v, 0.f) + log1pf(__expf(-fabsf(v))); }

struct Args { const float* in[19]; float* out; unsigned char* ws; int ph_lo, ph_hi; };

__device__ __forceinline__ void transpose_item(const float* W, int ldw, int col0, int K, bf16* WT, int row_off, LAS float* scr, int kb, int nb, int lane, int src_row_off = 0, const float* kscale = nullptr) {
    const int k0 = 64 * kb, n0 = 32 * nb;
    float tv[32];
#pragma unroll
    for (int i = 0; i < 32; ++i) { const int kk = 2 * i + (lane >> 5); tv[i] = W[(size_t)(src_row_off + k0 + kk) * ldw + col0 + n0 + (lane & 31)]; }
#pragma unroll
    for (int i = 0; i < 32; ++i) { const int kk = 2 * i + (lane >> 5); const float sc = kscale ? kscale[k0 + kk] : 1.0f; scr[kk * 33 + (lane & 31)] = sc * tv[i]; }
    asm volatile("s_waitcnt lgkmcnt(0)" ::: "memory");
    const int c = lane & 7;
#pragma unroll
    for (int j = 0; j < 4; ++j) { const int n = (lane >> 3) + 8 * j; const LAS float* s = scr + (8 * c) * 33 + n;
        v4u o; o.x = pk2(s[0 * 33], s[1 * 33]); o.y = pk2(s[2 * 33], s[3 * 33]); o.z = pk2(s[4 * 33], s[5 * 33]); o.w = pk2(s[6 * 33], s[7 * 33]);
        *(v4u*)(WT + (size_t)(row_off + n0 + n) * K + k0 + 8 * c) = o; }
    asm volatile("s_waitcnt lgkmcnt(0)" ::: "memory");
}

template <bool SILU>
__device__ __forceinline__ void small_proj(LAS unsigned char* lds, const float* src, int sstride, const float* W, int ldw, int ncols, const float* bias, float* out, int ostride, int G) {
    const int tid = threadIdx.x, lane = tid & 63, wave = tid >> 6, nitems = ncols / 32;
    LAS float* cst = (LAS float*)lds;
    LAS float* part = (LAS float*)(lds + 65536);
    if ((int)blockIdx.x < nitems) {
        for (int i = tid; i < 16384; i += NTHR) { const int b = i >> 10, k = i & 1023; const float v = src[(size_t)b * sstride + k]; cst[k * 16 + b] = SILU ? silu_f(v) : v; }
        __syncthreads();
    }
    for (int it = blockIdx.x; it < nitems; it += G) {
        const int col0 = it * 32, kh = lane >> 5, col = lane & 31, kbase = wave * 128 + kh * 64;
        float acc[16];
#pragma unroll
        for (int b = 0; b < 16; ++b) acc[b] = 0.f;
        for (int i0 = 0; i0 < 64; i0 += 16) {
            float wv[16];
#pragma unroll
            for (int j = 0; j < 16; ++j) wv[j] = W[(size_t)(kbase + i0 + j) * ldw + col0 + col];
#pragma unroll
            for (int j = 0; j < 16; ++j) { const int k = kbase + i0 + j;
#pragma unroll
                for (int q = 0; q < 4; ++q) { const f32x4 c4 = *(const LAS f32x4*)(cst + k * 16 + 4 * q); acc[4 * q + 0] += c4.x * wv[j]; acc[4 * q + 1] += c4.y * wv[j]; acc[4 * q + 2] += c4.z * wv[j]; acc[4 * q + 3] += c4.w * wv[j]; } }
        }
#pragma unroll
        for (int b = 0; b < 16; ++b) part[((wave * 2 + kh) * 16 + b) * 32 + col] = acc[b];
        __syncthreads();
        { const int b = tid >> 5, cc = tid & 31; float sm = bias ? bias[col0 + cc] : 0.f;
#pragma unroll
          for (int p = 0; p < 16; ++p) sm += part[(p * 16 + b) * 32 + cc];
          out[(size_t)b * ostride + col0 + cc] = sm; }
        __syncthreads();
    }
    __syncthreads();
}

__device__ __forceinline__ void p0_prologue(LAS unsigned char* lds, const Args& a, int G) {
    const int tid = threadIdx.x, lane = tid & 63, wave = tid >> 6;
    unsigned char* ws = a.ws;
    const float* w_in = a.in[5];
    bf16* WtIn = (bf16*)(ws + WS_WIN);
    {
        LAS float* wp = (LAS float*)lds;
        LAS float* win = (LAS float*)(lds + 65536);
        for (int it = blockIdx.x; it < 256; it += G) {
            const int g = it >> 6, k0 = (it & 63) * 16;
            const float* wpg = a.in[12] + (size_t)g * 16384;
            for (int i = tid; i < 16384; i += NTHR) wp[i] = wpg[i];
            for (int i = tid; i < 2048; i += NTHR) { const int kk = i >> 7, c = i & 127; win[i] = w_in[(size_t)(k0 + kk) * INW + g * 128 + c]; }
            __syncthreads();
            const int kk = tid >> 5, d4 = (tid & 31) * 4;
            f32x4 acc = {0.f, 0.f, 0.f, 0.f};
#pragma unroll 8
            for (int c = 0; c < 128; ++c) { const float av = win[kk * 128 + c]; const f32x4 w4 = *(const LAS f32x4*)(wp + c * 128 + d4); acc += av * w4; }
#pragma unroll
            for (int e = 0; e < 4; ++e) WtIn[(size_t)(g * 128 + d4 + e) * D + k0 + kk] = (bf16)f2bf(acc[e]);
            __syncthreads();
        }
    }
    small_proj<true>(lds, a.in[1], D, a.in[2], NMOD, NMOD, a.in[3], (float*)(ws + WS_MOD), NMOD, G);
    __syncthreads();
    {
        LAS float* scr = (LAS float*)(lds + wave * 16384);
        const int gw = blockIdx.x * NWAVES + wave, NGW = G * NWAVES;
        constexpr int I_IN = 16 * 80, I_OUT = 24 * 32, I_UP = 16 * 128, I_DN = 64 * 32;
        for (int it = gw; it < I_IN + I_OUT + I_UP + I_DN; it += NGW) {
            int r = it;
            if (r < I_IN) { transpose_item(w_in, INW, 512, D, WtIn, 512, scr, r / 80, r % 80, lane); continue; } r -= I_IN;
            if (r < I_OUT) { const int kb = r / 32;
                transpose_item(a.in[14], D, 0, MIXW, (bf16*)(ws + WS_WOUT), 0, scr, kb, r % 32, lane, kb < 16 ? 512 : -1024, kb < 16 ? a.in[11] : nullptr); continue; } r -= I_OUT;
            if (r < I_UP) { transpose_item(a.in[16], FF, 0, D, (bf16*)(ws + WS_WUP), 0, scr, r / 128, r % 128, lane); continue; } r -= I_UP;
            transpose_item(a.in[17], D, 0, FF, (bf16*)(ws + WS_WDN), 0, scr, r / 32, r % 32, lane);
        }
    }
}

template <bool WITH_DT>
__device__ __forceinline__ void normmod_phase(LAS unsigned char* lds, const float* src, const float* gvec, const float* MOD, int shift_ofs, int scale_ofs, bf16* XN,
                                              const float* w_in, const float* dt_bias, float* DT, int G) {
    const int tid = threadIdx.x, lane = tid & 63, wave = tid >> 6;
    LAS float* WdtL = (LAS float*)lds;
    if (WITH_DT) {
        for (int i = tid; i < 16384; i += NTHR) { const int k = i >> 4, h = i & 15; WdtL[h * 1024 + k] = w_in[(size_t)k * INW + NPROJ + h]; }
        __syncthreads();
    }
    const int gw = blockIdx.x * NWAVES + wave, NGW = G * NWAVES;
    for (int rg = gw; rg < M / 16; rg += NGW) {
        const int m0 = rg * 16, b = m0 / SEQ;
        const float* mp = MOD + (size_t)b * NMOD;
        f32x4 gs[4], sh[4];
#pragma unroll
        for (int j = 0; j < 4; ++j) { const int k = 4 * lane + 256 * j; const f32x4 g4 = *(const f32x4*)(gvec + k); const f32x4 sc = *(const f32x4*)(mp + scale_ofs + k); gs[j] = g4 * (sc + 1.0f); sh[j] = *(const f32x4*)(mp + shift_ofs + k); }
        f32x4 vn[4];
        { const f32x4* xr = (const f32x4*)(src + (size_t)m0 * D) + lane;
#pragma unroll
          for (int j = 0; j < 4; ++j) vn[j] = xr[64 * j]; }
        for (int r = 0; r < 16; ++r) {
            const int m = m0 + r;
            f32x4 v[4]; float ss = 0.f;
#pragma unroll
            for (int j = 0; j < 4; ++j) v[j] = vn[j];
            if (r + 1 < 16) { const f32x4* xr = (const f32x4*)(src + (size_t)(m + 1) * D) + lane;
#pragma unroll
                for (int j = 0; j < 4; ++j) vn[j] = xr[64 * j]; }
#pragma unroll
            for (int j = 0; j < 4; ++j) ss += (v[j].x * v[j].x + v[j].y * v[j].y) + (v[j].z * v[j].z + v[j].w * v[j].w);
            ss = wave_sum(ss);
            const float rinv = 1.0f / sqrtf(ss * (1.0f / D) + EPS);
#pragma unroll
            for (int j = 0; j < 4; ++j) v[j] = v[j] * rinv * gs[j] + sh[j];
            unsigned long long* o8 = (unsigned long long*)(XN + (size_t)m * D) + lane;
#pragma unroll
            for (int j = 0; j < 4; ++j) o8[64 * j] = (unsigned long long)pk2(v[j].x, v[j].y) | ((unsigned long long)pk2(v[j].z, v[j].w) << 32);
            if (WITH_DT) {
                float acc[16];
#pragma unroll
                for (int h = 0; h < 16; ++h) { float s = 0.f;
#pragma unroll
                    for (int j = 0; j < 4; ++j) { const f32x4 w4 = *(const LAS f32x4*)(WdtL + h * 1024 + 4 * lane + 256 * j); s += (v[j].x * w4.x + v[j].y * w4.y) + (v[j].z * w4.z + v[j].w * w4.w); }
                    acc[h] = s; if ((h & 3) == 3) asm volatile("" ::: "memory"); }
                float a8[8], a4[4], a2[2], a1;
                const bool u5 = (lane & 32) != 0, u4 = (lane & 16) != 0, u3 = (lane & 8) != 0, u2 = (lane & 4) != 0;
#pragma unroll
                for (int i = 0; i < 8; ++i) { const float keep = u5 ? acc[i + 8] : acc[i], send = u5 ? acc[i] : acc[i + 8]; a8[i] = keep + __shfl_xor(send, 32); }
#pragma unroll
                for (int i = 0; i < 4; ++i) { const float keep = u4 ? a8[i + 4] : a8[i], send = u4 ? a8[i] : a8[i + 4]; a4[i] = keep + __shfl_xor(send, 16); }
#pragma unroll
                for (int i = 0; i < 2; ++i) { const float keep = u3 ? a4[i + 2] : a4[i], send = u3 ? a4[i] : a4[i + 2]; a2[i] = keep + __shfl_xor(send, 8); }
                { const float keep = u2 ? a2[1] : a2[0], send = u2 ? a2[0] : a2[1]; a1 = keep + __shfl_xor(send, 4); }
                a1 += __shfl_xor(a1, 2); a1 += __shfl_xor(a1, 1);
                const int h = ((lane >> 5) & 1) * 8 + ((lane >> 4) & 1) * 4 + ((lane >> 3) & 1) * 2 + ((lane >> 2) & 1);
                if ((lane & 3) == 0) DT[(size_t)m * 16 + h] = softplus_f(a1 + dt_bias[h]);
            }
        }
    }
}

template <int TAPS, bool POOL>
__device__ __forceinline__ void fir_rows(const Args& a, int G, int cgi, int rsub) {
    const bf16* PROJ = (const bf16*)(a.ws + WS_PROJ);
    const int c0 = cgi * 8;
    const bf16* src = PROJ + (POOL ? 0 : 1536) + c0;
    bf16* dst = POOL ? (bf16*)(a.ws + WS_YMIX) + 1024 + c0 : (bf16*)(a.ws + WS_CONV) + c0;
    const int dstride = POOL ? MIXW : CONVCH;
    const int w = POOL ? (2 << (c0 >> 7)) : 4;
    float pa[8], pb[4][8];
#pragma unroll
    for (int e = 0; e < 8; ++e) { pa[e] = POOL ? a.in[13][c0 + e] : a.in[7][c0 + e];
#pragma unroll
        for (int k = 0; k < 4; ++k) pb[k][e] = POOL ? 0.f : a.in[6][k * CONVCH + c0 + e]; }
    v4u LN[TAPS + 3];
#define FIR_LOAD(m0_) do { const int mq_ = (m0_), sq_ = mq_ & (SEQ - 1); \
        _Pragma("unroll") for (int r = 0; r < TAPS + 3; ++r) { const int rel = r - (TAPS - 1); \
            if (sq_ + rel >= 0) LN[r] = *(const v4u*)(src + (size_t)(mq_ + rel) * NPROJ); else LN[r] = (v4u){0u, 0u, 0u, 0u}; } } while (0)
    if (!POOL && (int)blockIdx.x < M / 128) FIR_LOAD(blockIdx.x * 128 + rsub * 4);
    for (int blk = blockIdx.x; blk < M / 128; blk += G)
        for (int i = 0; i < 16; ++i) {
            const int m0 = blk * 128 + (i * 2 + rsub) * 4, s0 = m0 & (SEQ - 1);
            v4u L[TAPS + 3];
            if (POOL) FIR_LOAD(m0);
#pragma unroll
            for (int r = 0; r < TAPS + 3; ++r) L[r] = LN[r];
            if (!POOL) { if (i + 1 < 16) FIR_LOAD(m0 + 8); else if (blk + G < M / 128) FIR_LOAD((blk + G) * 128 + rsub * 4); }
#pragma unroll
            for (int o = 0; o < 4; ++o) {
                float acc[8];
                if (POOL) {
                    const int nv = min(s0 + o + 1, w); const float inv = 1.0f / (float)nv;
#pragma unroll
                    for (int e = 0; e < 8; ++e) acc[e] = 0.f;
#pragma unroll
                    for (int j = 0; j < TAPS; ++j) { float t[8]; unpack8(L[TAPS - 1 + o - j], t); const float cj = (j < nv) ? 1.0f : 0.0f;
#pragma unroll
                        for (int e = 0; e < 8; ++e) acc[e] += cj * t[e]; }
                    float cur[8]; unpack8(L[TAPS - 1 + o], cur);
#pragma unroll
                    for (int e = 0; e < 8; ++e) acc[e] = (acc[e] * inv - cur[e]) * pa[e];
                } else {
#pragma unroll
                    for (int e = 0; e < 8; ++e) acc[e] = pa[e];
#pragma unroll
                    for (int k = 0; k < 4; ++k) { float t[8]; unpack8(L[o + k], t);
#pragma unroll
                        for (int e = 0; e < 8; ++e) acc[e] += pb[k][e] * t[e]; }
#pragma unroll
                    for (int e = 0; e < 8; ++e) acc[e] = silu_f(acc[e]);
                }
                *(v4u*)(dst + (size_t)(m0 + o) * dstride) = pack8(acc);
            }
        }
}
#undef FIR_LOAD
__device__ __forceinline__ void halo_phase(const Args& a, int G) {
    const int tid = threadIdx.x, cgp = tid & 255, rsub = tid >> 8;
    if (cgp < 64) fir_rows<16, true>(a, G, cgp, rsub); else fir_rows<4, false>(a, G, cgp - 64, rsub);
}

__device__ __forceinline__ void ssd_naive_phase(LAS unsigned char* lds, const Args& a, int G) {
    const int tid = threadIdx.x;
    LAS float* xs = (LAS float*)lds;
    LAS float* Bs = (LAS float*)(lds + 16384);
    LAS float* Cs = (LAS float*)(lds + 49152);
    LAS float* yb = (LAS float*)(lds + 81920);
    LAS float* dts = (LAS float*)(lds + 98304);
    LAS float* dAs = (LAS float*)(lds + 98304 + 256);
    const bf16* PROJ = (const bf16*)(a.ws + WS_PROJ); const bf16* CONV = (const bf16*)(a.ws + WS_CONV);
    bf16* YMIX = (bf16*)(a.ws + WS_YMIX); const float* DT = (const float*)(a.ws + WS_DT); float* SSQ = (float*)(a.ws + WS_SSQ);
    const int p = tid >> 3, nq = tid & 7, n0 = nq * 16;
    for (int it = blockIdx.x; it < BATCH * NHEADS; it += G) {
        const int b = it >> 4, hh = it & 15, g = hh >> 3;
        const float av = -__expf(a.in[9][hh]), dsk = a.in[10][hh];
        float h[16];
#pragma unroll
        for (int i = 0; i < 16; ++i) h[i] = 0.f;
        for (int ck = 0; ck < SEQ / 64; ++ck) {
            const size_t m0 = (size_t)b * SEQ + ck * 64;
            { const int t = tid >> 3, part = tid & 7; float f[8]; unpack8(*(const v4u*)(CONV + (m0 + t) * CONVCH + hh * 64 + part * 8), f);
#pragma unroll
              for (int e = 0; e < 8; ++e) xs[t * 64 + part * 8 + e] = f[e]; }
#pragma unroll
            for (int i = 0; i < 2; ++i) { const int piece = tid + i * NTHR, t = piece >> 4, part = piece & 15; float f[8];
                unpack8(*(const v4u*)(CONV + (m0 + t) * CONVCH + 1024 + g * 128 + part * 8), f);
#pragma unroll
                for (int e = 0; e < 8; ++e) Bs[t * 128 + part * 8 + e] = f[e];
                unpack8(*(const v4u*)(CONV + (m0 + t) * CONVCH + 1280 + g * 128 + part * 8), f);
#pragma unroll
                for (int e = 0; e < 8; ++e) Cs[t * 128 + part * 8 + e] = f[e]; }
            if (tid < 64) { const float dtv = DT[(m0 + tid) * 16 + hh]; dts[tid] = dtv; dAs[tid] = __expf(dtv * av); }
            __syncthreads();
            for (int t = 0; t < 64; ++t) {
                const float xr = xs[t * 64 + p], xv = xr * dts[t], dA = dAs[t];
                float yp = 0.f;
#pragma unroll
                for (int q = 0; q < 4; ++q) { const f32x4 b4 = *(const LAS f32x4*)(Bs + t * 128 + n0 + 4 * q), c4 = *(const LAS f32x4*)(Cs + t * 128 + n0 + 4 * q);
#pragma unroll
                    for (int e = 0; e < 4; ++e) { h[4 * q + e] = h[4 * q + e] * dA + xv * b4[e]; yp += h[4 * q + e] * c4[e]; } }
                yp += __shfl_xor(yp, 1); yp += __shfl_xor(yp, 2); yp += __shfl_xor(yp, 4);
                if (nq == 0) yb[t * 64 + p] = yp + dsk * xr;
            }
            __syncthreads();
            { const int t = tid >> 3, part = tid & 7; float z[8], y[8]; unpack8(*(const v4u*)(PROJ + (m0 + t) * NPROJ + 512 + hh * 64 + part * 8), z);
              float sq = 0.f;
#pragma unroll
              for (int e = 0; e < 8; ++e) { y[e] = yb[t * 64 + part * 8 + e] * silu_f(z[e]); sq += y[e] * y[e]; }
              sq += __shfl_xor(sq, 1); sq += __shfl_xor(sq, 2); sq += __shfl_xor(sq, 4);
              if (part == 0) SSQ[(m0 + t) * 16 + hh] = sq;
              *(v4u*)(YMIX + (m0 + t) * MIXW + 512 + hh * 64 + part * 8) = pack8(y); }
            __syncthreads();
        }
    }
}

typedef short s16x4 __attribute__((ext_vector_type(4)));
typedef short bf16x8 __attribute__((ext_vector_type(8)));
__device__ __forceinline__ bf16x8 frag_row(LAS unsigned char* base, int stride, int row0, int k0, int x, int y) { return *(const LAS bf16x8*)(base + (row0 + x) * stride + (k0 + 8 * y) * 2); }
__device__ __forceinline__ bf16x8 frag_tr(LAS unsigned char* base, int stride, int krow0, int col0, int lane) {
    const int y = lane >> 4, q = (lane >> 2) & 3, p = lane & 3;
    LAS unsigned char* a0 = base + (krow0 + 4 * y + q) * stride + (col0 + 4 * p) * 2;
    const s16x4 r0 = __builtin_amdgcn_ds_read_tr16_b64_v4i16((LAS s16x4*)a0);
    const s16x4 r1 = __builtin_amdgcn_ds_read_tr16_b64_v4i16((LAS s16x4*)(a0 + 16 * stride));
    return __builtin_shufflevector(r0, r1, 0, 1, 2, 3, 4, 5, 6, 7);
}
__device__ __forceinline__ void ssd_chunk_phase(LAS unsigned char* lds, const Args& a, int G) {
    const int tid = threadIdx.x, lane = tid & 63, w = __builtin_amdgcn_readfirstlane(tid >> 6), x = lane & 15, y = lane >> 4;
    constexpr int CS = 0, CSS = 272, BS = 34816, BSS = 288, XS = 71680, XSS = 160, XW = 92160, HB = 112640, HBS = 272, TAB = 130048;
    LAS float* t_acum = (LAS float*)(lds + TAB); LAS float* t_dt = t_acum + 128; LAS float* t_ea = t_acum + 256; LAS float* t_wl = t_acum + 384; LAS float* t_misc = t_acum + 512;
    const bf16* PROJ = (const bf16*)(a.ws + WS_PROJ); const bf16* CONV = (const bf16*)(a.ws + WS_CONV);
    bf16* YMIX = (bf16*)(a.ws + WS_YMIX); const float* DT = (const float*)(a.ws + WS_DT); float* SSQ = (float*)(a.ws + WS_SSQ);
    for (int it0 = blockIdx.x; it0 < BATCH * NHEADS; it0 += G) {
        const int xcd = it0 & 7, slot = it0 >> 3, qq = xcd * 4 + (slot >> 3), b = qq >> 1, g = qq & 1, hh = g * 8 + (slot & 7);
        const float av = -__expf(a.in[9][hh]), dsk = a.in[10][hh];
        f32x4 hst[4];
#pragma unroll
        for (int nt = 0; nt < 4; ++nt) hst[nt] = (f32x4){0.f, 0.f, 0.f, 0.f};
        v4u rc[4], rb[4], rx[2]; float d0 = 0.f, d1 = 0.f;
        const bf16* cbase = CONV + (size_t)b * SEQ * CONVCH;
#define SSD_LOAD(ck_) do { const bf16* cb_ = cbase + (size_t)(ck_) * 128 * CONVCH; \
            _Pragma("unroll") for (int i = 0; i < 4; ++i) { const int piece = tid + i * NTHR, row = piece >> 4, part = piece & 15; \
                rc[i] = *(const v4u*)(cb_ + (size_t)row * CONVCH + 1280 + g * 128 + part * 8); rb[i] = *(const v4u*)(cb_ + (size_t)row * CONVCH + 1024 + g * 128 + part * 8); } \
            _Pragma("unroll") for (int i = 0; i < 2; ++i) { const int piece = tid + i * NTHR, row = piece >> 3, part = piece & 7; rx[i] = *(const v4u*)(cb_ + (size_t)row * CONVCH + hh * 64 + part * 8); } \
            if (w == 0) { const size_t mm_ = (size_t)b * SEQ + (ck_) * 128 + 2 * lane; d0 = DT[mm_ * 16 + hh]; d1 = DT[(mm_ + 1) * 16 + hh]; } } while (0)
        SSD_LOAD(0);
        for (int ck = 0; ck < SEQ / 128; ++ck) {
            const size_t m0 = (size_t)b * SEQ + ck * 128;
            const int lt = (w < 4) ? w : 11 - w;
            const int l = 16 * lt + x;
            v2u rz[4];
#pragma unroll
            for (int pt = 0; pt < 4; ++pt) rz[pt] = *(const v2u*)(PROJ + (m0 + l) * NPROJ + 512 + hh * 64 + 16 * pt + 4 * y);
            if (w == 0) {
                const float a0 = d0 * av, a1 = d1 * av; float sc = a0 + a1;
#pragma unroll
                for (int o = 1; o < 64; o <<= 1) { const float t = __shfl_up(sc, o); if (lane >= o) sc += t; }
                const float c1 = sc, c0 = sc - a1, alast = __shfl(sc, 63);
                t_acum[2 * lane] = c0; t_acum[2 * lane + 1] = c1; t_dt[2 * lane] = d0; t_dt[2 * lane + 1] = d1;
                t_ea[2 * lane] = __expf(c0); t_ea[2 * lane + 1] = __expf(c1);
                t_wl[2 * lane] = d0 * __expf(alast - c0); t_wl[2 * lane + 1] = d1 * __expf(alast - c1);
                if (lane == 0) t_misc[0] = __expf(alast);
            }
#pragma unroll
            for (int i = 0; i < 4; ++i) { const int piece = tid + i * NTHR, row = piece >> 4, part = piece & 15;
                *(LAS v4u*)(lds + CS + row * CSS + part * 16) = rc[i]; *(LAS v4u*)(lds + BS + row * BSS + part * 16) = rb[i]; }
#pragma unroll
            for (int i = 0; i < 2; ++i) { const int piece = tid + i * NTHR, row = piece >> 3, part = piece & 7; *(LAS v4u*)(lds + XS + row * XSS + part * 16) = rx[i]; }
#pragma unroll
            for (int nt = 0; nt < 4; ++nt) { const int p = 16 * (w & 3) + x, n = 16 * (4 * (w >> 2) + nt) + 4 * y;
                *(LAS v2u*)(lds + HB + p * HBS + n * 2) = (v2u){pk2(hst[nt].x, hst[nt].y), pk2(hst[nt].z, hst[nt].w)}; }
            __syncthreads();
#pragma unroll
            for (int i = 0; i < 2; ++i) { const int piece = tid + i * NTHR, row = piece >> 3, part = piece & 7; const float wl = t_wl[row]; float f[8]; unpack8(rx[i], f);
#pragma unroll
                for (int e = 0; e < 8; ++e) f[e] *= wl;
                *(LAS v4u*)(lds + XW + row * XSS + part * 16) = pack8(f); }
            __syncthreads();
            if (ck + 1 < SEQ / 128) SSD_LOAD(ck + 1);
            bf16x8 cf[4];
#pragma unroll
            for (int ks = 0; ks < 4; ++ks) cf[ks] = frag_row(lds + CS, CSS, 16 * lt, 32 * ks, x, y);
            f32x4 sacc[8];
#pragma unroll
            for (int ts = 0; ts < 8; ++ts) { sacc[ts] = (f32x4){0.f, 0.f, 0.f, 0.f};
                if (ts <= lt) {
#pragma unroll
                for (int ks = 0; ks < 4; ++ks) sacc[ts] = __builtin_amdgcn_mfma_f32_16x16x32_bf16(frag_row(lds + BS, BSS, 16 * ts, 32 * ks, x, y), cf[ks], sacc[ts], 0, 0, 0); } }
            f32x4 yacc[4];
            const float ea_l = t_ea[l], ac_l = t_acum[l];
#pragma unroll
            for (int pt = 0; pt < 4; ++pt) { yacc[pt] = (f32x4){0.f, 0.f, 0.f, 0.f};
#pragma unroll
                for (int ks = 0; ks < 4; ++ks) yacc[pt] = __builtin_amdgcn_mfma_f32_16x16x32_bf16(frag_row(lds + HB, HBS, 16 * pt, 32 * ks, x, y), cf[ks], yacc[pt], 0, 0, 0);
                yacc[pt] = yacc[pt] * ea_l; }
#pragma unroll
            for (int ts = 0; ts < 8; ++ts) if (ts <= (lt | 1)) { const f32x4 as = *(const LAS f32x4*)(t_acum + 16 * ts + 4 * y), ds = *(const LAS f32x4*)(t_dt + 16 * ts + 4 * y); float gv[4];
#pragma unroll
                for (int e = 0; e < 4; ++e) { const int s = 16 * ts + 4 * y + e; const float ev = (s <= l) ? __expf(ac_l - as[e]) : 0.f; gv[e] = sacc[ts][e] * ev * ds[e]; }
                const int c = 32 * (ts >> 1) + 8 * y + 4 * (ts & 1);
                *(LAS v2u*)(lds + CS + l * CSS + c * 2) = (v2u){pk2(gv[0], gv[1]), pk2(gv[2], gv[3])}; }
            { const float cd = t_misc[0];
#pragma unroll
              for (int nt = 0; nt < 4; ++nt) hst[nt] = hst[nt] * cd;
#pragma unroll
              for (int ks = 0; ks < 4; ++ks) { const bf16x8 xf = frag_tr(lds + XW, XSS, 32 * ks, 16 * (w & 3), lane);
#pragma unroll
                  for (int nt = 0; nt < 4; ++nt) hst[nt] = __builtin_amdgcn_mfma_f32_16x16x32_bf16(frag_tr(lds + BS, BSS, 32 * ks, 16 * (4 * (w >> 2) + nt), lane), xf, hst[nt], 0, 0, 0); } }
#pragma unroll
            for (int ks = 0; ks < 4; ++ks) if (ks <= (lt >> 1)) { const bf16x8 gf = frag_row(lds + CS, CSS, 16 * lt, 32 * ks, x, y);
#pragma unroll
                for (int pt = 0; pt < 4; ++pt) yacc[pt] = __builtin_amdgcn_mfma_f32_16x16x32_bf16(frag_tr(lds + XS, XSS, 32 * ks, 16 * pt, lane), gf, yacc[pt], 0, 0, 0); }
            { const size_t m = m0 + l; float sq = 0.f;
#pragma unroll
              for (int pt = 0; pt < 4; ++pt) { const v2u xr = *(const LAS v2u*)(lds + XS + l * XSS + (16 * pt + 4 * y) * 2);
                  const float y0 = (yacc[pt].x + dsk * bflo(xr.x)) * silu_f(bflo(rz[pt].x)), y1 = (yacc[pt].y + dsk * bfhi(xr.x)) * silu_f(bfhi(rz[pt].x));
                  const float y2 = (yacc[pt].z + dsk * bflo(xr.y)) * silu_f(bflo(rz[pt].y)), y3 = (yacc[pt].w + dsk * bfhi(xr.y)) * silu_f(bfhi(rz[pt].y));
                  sq += (y0 * y0 + y1 * y1) + (y2 * y2 + y3 * y3);
                  *(v2u*)(YMIX + m * MIXW + hh * 64 + 16 * pt + 4 * y) = (v2u){pk2(y0, y1), pk2(y2, y3)}; }
              sq += __shfl_xor(sq, 16); sq += __shfl_xor(sq, 32);
              if (y == 0) SSQ[m * 16 + hh] = sq; }
            __syncthreads();
        }
#undef SSD_LOAD
    }
}

__device__ __forceinline__ void ssdnorm_phase(const Args& a, int G) {
    const int tid = threadIdx.x, rsub = tid >> 7, c8 = (tid & 127) * 8, g = c8 >> 9;
    bf16* YMIX = (bf16*)(a.ws + WS_YMIX); const float* SSQ = (const float*)(a.ws + WS_SSQ);
    float gsd[8];
#pragma unroll
    for (int e = 0; e < 8; ++e) gsd[e] = a.in[11][c8 + e];
    for (int r4 = blockIdx.x; r4 < M / 4; r4 += G) {
        const size_t m = (size_t)r4 * 4 + rsub;
        const f32x4 s0 = *(const f32x4*)(SSQ + m * 16 + g * 8), s1 = *(const f32x4*)(SSQ + m * 16 + g * 8 + 4);
        const float ss = ((s0.x + s0.y) + (s0.z + s0.w)) + ((s1.x + s1.y) + (s1.z + s1.w));
        const float rinv = 1.0f / sqrtf(ss * (1.0f / 512.0f) + EPS);
        float y[8]; v4u* pp = (v4u*)(YMIX + m * MIXW + 512 + c8); unpack8(*pp, y);
#pragma unroll
        for (int e = 0; e < 8; ++e) y[e] = y[e] * rinv * gsd[e];
        *pp = pack8(y);
    }
}

__device__ __forceinline__ void finalnorm_phase(const Args& a, int G) {
    const int tid = threadIdx.x, lane = tid & 63, wave = tid >> 6;
    const int gw = blockIdx.x * NWAVES + wave, NGW = G * NWAVES;
    f32x4 gf[4];
#pragma unroll
    for (int j = 0; j < 4; ++j) gf[j] = *(const f32x4*)(a.in[18] + 4 * lane + 256 * j);
    f32x4 vn[4];
    if (gw < M) { const f32x4* xr0 = (const f32x4*)(a.out + (size_t)gw * D) + lane;
#pragma unroll
        for (int j = 0; j < 4; ++j) vn[j] = xr0[64 * j]; }
    for (int m = gw; m < M; m += NGW) {
        f32x4* xr = (f32x4*)(a.out + (size_t)m * D) + lane;
        f32x4 v[4]; float ss = 0.f;
#pragma unroll
        for (int j = 0; j < 4; ++j) v[j] = vn[j];
        if (m + NGW < M) { const f32x4* xq = (const f32x4*)(a.out + (size_t)(m + NGW) * D) + lane;
#pragma unroll
            for (int j = 0; j < 4; ++j) vn[j] = xq[64 * j]; }
#pragma unroll
        for (int j = 0; j < 4; ++j) ss += (v[j].x * v[j].x + v[j].y * v[j].y) + (v[j].z * v[j].z + v[j].w * v[j].w);
        ss = wave_sum(ss);
        const float rinv = 1.0f / sqrtf(ss * (1.0f / D) + EPS);
#pragma unroll
        for (int j = 0; j < 4; ++j) xr[64 * j] = v[j] * rinv * gf[j];
    }
}

#define XB_TMO      128
#define XB_XCNT(j)  (256  + 64 * (j))
#define XB_XSUB(j)  (1280 + 64 * (j))
#define XB_XGEN(j)  (2304 + 64 * (j))
#define XB_TOP      3328
#define XB_TOPGEN   3392
#define XCD_BAR_WORDS 3456
#define XB_SPIN_CAP (1u << 18)

__device__ __forceinline__ unsigned xb_ld(unsigned* p)              { return __hip_atomic_load(p, __ATOMIC_RELAXED, __HIP_MEMORY_SCOPE_AGENT); }
__device__ __forceinline__ unsigned xb_add(unsigned* p, unsigned v) { return __hip_atomic_fetch_add(p, v, __ATOMIC_RELAXED, __HIP_MEMORY_SCOPE_AGENT); }
__device__ __forceinline__ unsigned xb_xcc_id() { return (unsigned)__builtin_amdgcn_s_getreg((3 << 11) | 20) & 0xFu; }
#define XB_SPIN(cond, bar) do { unsigned _sp = 0; while (cond) { __builtin_amdgcn_s_sleep(1); \
    if ((++_sp & 255u) == 0u) { if (xb_ld(&(bar)[XB_TMO])) break; if (_sp > XB_SPIN_CAP) { atomicAdd(&(bar)[XB_TMO], 1u); break; } } } } while (0)

struct XcdBarrier {
    unsigned* bar; unsigned x;
    volatile LAS unsigned* st;
};

__device__ __forceinline__ XcdBarrier xcd_barrier_post(unsigned* bar, volatile LAS unsigned* st) {
    XcdBarrier b; b.bar = bar; b.x = xb_xcc_id(); b.st = st;
    if (threadIdx.x == 0) (void)xb_add(&bar[XB_XCNT(b.x)], 1u);
    return b;
}
__device__ __forceinline__ void xcd_barrier_complete(unsigned* bar, unsigned x, unsigned& nloc, unsigned& nx) {
    const unsigned G = gridDim.x * gridDim.y * gridDim.z;
    unsigned sum, cnt, mine, sp = 0u;
    for (;;) {
        sum = 0u; cnt = 0u; mine = 0u;
#pragma unroll
        for (unsigned j = 0; j < 16; ++j) { const unsigned c = xb_ld(&bar[XB_XCNT(j)]); sum += c; cnt += (c > 0u) ? 1u : 0u; mine = (j == x) ? c : mine; }
        if (sum == G) break;
        __builtin_amdgcn_s_sleep(1);
        if ((++sp & 255u) == 0u) { if (xb_ld(&bar[XB_TMO])) break; if (sp > XB_SPIN_CAP) { atomicAdd(&bar[XB_TMO], 1u); break; } }
    }
    nloc = mine > 0u ? mine : 1u; nx = cnt > 0u ? cnt : 1u;
}

__device__ __forceinline__ void xcd_barrier(const XcdBarrier& b) {
    asm volatile("s_waitcnt vmcnt(0)" ::: "memory");
    __syncthreads();
    if (threadIdx.x == 0) {
        unsigned* bar = b.bar;
        __builtin_amdgcn_s_waitcnt(0);
        unsigned nloc = b.st[0], nx = b.st[1];
        if (nloc == 0u) { xcd_barrier_complete(bar, b.x, nloc, nx); b.st[0] = nloc; b.st[1] = nx; }
        const unsigned old = xb_add(&bar[XB_XSUB(b.x)], 1u);
        const unsigned gen = old / nloc;
        if (old + 1u == (gen + 1u) * nloc) {
            __builtin_amdgcn_fence(__ATOMIC_RELEASE, "agent");
            asm volatile("s_waitcnt vmcnt(0)" ::: "memory");
            const unsigned og = xb_add(&bar[XB_TOP], 1u);
            const unsigned tg = og / nx;
            if (og + 1u == (tg + 1u) * nx) xb_add(&bar[XB_TOPGEN], 1u);
            else XB_SPIN(xb_ld(&bar[XB_TOPGEN]) == tg, bar);
            __builtin_amdgcn_fence(__ATOMIC_ACQUIRE, "agent");
            xb_add(&bar[XB_XGEN(b.x)], 1u);
            asm volatile("s_waitcnt vmcnt(0)" ::: "memory");
        } else {
            XB_SPIN(xb_ld(&bar[XB_XGEN(b.x)]) == gen, bar);
            __builtin_amdgcn_fence(__ATOMIC_ACQUIRE, "agent");
            asm volatile("s_waitcnt vmcnt(0)" ::: "memory");
        }
    }
    __syncthreads();
}

constexpr int NPHASES = 11;
__global__ void __launch_bounds__(NTHR, 2) fwd_kernel(Args args) {
    extern __shared__ __attribute__((aligned(16))) unsigned char lds_raw[];
    LAS unsigned char* lds = (LAS unsigned char*)lds_raw;
    cg::grid_group grid = cg::this_grid();
    const int G = gridDim.x, lo = args.ph_lo, hi = args.ph_hi;
    unsigned char* ws = args.ws;
    float* MOD = (float*)(ws + WS_MOD);
#ifndef PH_MASK
#define PH_MASK 0x7ff
#endif
    constexpr int MISC_OFF = 135168;
    unsigned* barw = (unsigned*)(ws + WS_BAR);
    if (threadIdx.x < 2) ((volatile LAS unsigned*)(lds + MISC_OFF))[threadIdx.x] = 0u;
    if (blockIdx.x == 0) for (int i = threadIdx.x; i < XCD_BAR_WORDS; i += NTHR) __hip_atomic_store(barw + i, 0u, __ATOMIC_RELAXED, __HIP_MEMORY_SCOPE_AGENT);
    __syncthreads();
    XcdBarrier xbar; xbar.bar = barw; xbar.x = 0; xbar.st = (volatile LAS unsigned*)(lds + MISC_OFF);
#define IN(k) ((((PH_MASK) >> (k)) & 1) && lo <= (k) && (k) < hi)
#ifndef PROBE_DUP
#define PROBE_DUP -1
#endif
#define PH(k, ...) do { if (IN(k)) { __VA_ARGS__ if (PROBE_DUP == (k)) { if ((k) == 0) grid.sync(); else xcd_barrier(xbar); __VA_ARGS__ } } } while (0);
#define SEAM67() do { if (IN(6) && IN(8)) xcd_barrier(xbar); } while (0)
#define SEAMX(a_, b_) do { if (IN(a_) && IN(b_)) xcd_barrier(xbar); } while (0)
#define SEAM(k) do { if (IN(k) && IN((k) + 1)) xcd_barrier(xbar); } while (0)
    PH(0, { p0_prologue(lds, args, G); })
    if (IN(0) && IN(1)) { grid.sync(); xbar = xcd_barrier_post(barw, (volatile LAS unsigned*)(lds + MISC_OFF)); }
#ifdef PROBE_SYNCS
    for (int i_ = 0; i_ < PROBE_SYNCS; ++i_) xcd_barrier(xbar);
#endif
    PH(1, { small_proj<false>(lds, MOD + 3072, NMOD, args.in[16], FF, FF, nullptr, (float*)(ws + WS_SHW), FF, G); normmod_phase<true>(lds, args.in[0], args.in[4], MOD, 0, 1024, (bf16*)(ws + WS_XN), args.in[5], args.in[8], (float*)(ws + WS_DT), G); __syncthreads(); }) SEAM(1);
    PH(2, { pg8::Gemm g{(const bf16*)(ws + WS_XN), (const bf16*)(ws + WS_WIN), M, NPROJ, D}; pg8::StaticOrder S; S.init(M, NPROJ, G, (int)blockIdx.x);
        pg8::EpiBf16<0> E{(bf16*)(ws + WS_PROJ), NPROJ}; pg8::gemm_phase<pg8::EpiBf16<0>, pg8::StaticOrder, true, true>(lds, g, S, E); }) SEAM(2);
    PH(3, { halo_phase(args, G); }) SEAM(3);
    #ifdef SSD_NAIVE
    PH(4, { ssd_naive_phase(lds, args, G); }) SEAMX(4, 6);
#else
    PH(4, { ssd_chunk_phase(lds, args, G); }) SEAMX(4, 6);
#endif
    PH(6, { pg8::Gemm g{(const bf16*)(ws + WS_YMIX), (const bf16*)(ws + WS_WOUT), M, D, MIXW}; pg8::SsdOrder S; S.init(M, D, G, (int)blockIdx.x); S.ssq = (const float*)(ws + WS_SSQ); S.lds = lds; S.eps = EPS;
        pg8::EpiResGate2 E{args.in[0], args.out, MOD + 2048, args.in[15], MOD + 4096, (bf16*)(ws + WS_XN), (float*)(ws + WS_ROWP), SEQ, NMOD}; pg8::gemm_phase<pg8::EpiResGate2, pg8::SsdOrder, true, true>(lds, g, S, E); }) SEAM67();
    PH(8, { pg8::Gemm g{(const bf16*)(ws + WS_XN), (const bf16*)(ws + WS_WUP), M, FF, D}; pg8::StaticOrder S; S.init(M, FF, G, (int)blockIdx.x);
        pg8::EpiUp E{(bf16*)(ws + WS_F), FF, (const float*)(ws + WS_ROWP), (const float*)(ws + WS_SHW), SEQ, 1.0f / D, EPS}; pg8::gemm_phase<pg8::EpiUp, pg8::StaticOrder, true, true>(lds, g, S, E); }) SEAM(8);
    PH(9, { pg8::Gemm g{(const bf16*)(ws + WS_F), (const bf16*)(ws + WS_WDN), M, D, FF}; pg8::StaticOrder S; S.init(M, D, G, (int)blockIdx.x);
        pg8::EpiResGate E{args.out, args.out, MOD + 5120, SEQ, NMOD}; pg8::gemm_phase<pg8::EpiResGate, pg8::StaticOrder, true, true>(lds, g, S, E); }) SEAM(9);
    PH(10, { finalnorm_phase(args, G); })
#undef IN
#undef SEAM
}

#ifndef MK_ONE_LAUNCH
#define MK_ONE_LAUNCH 1
#endif
extern "C" void kernel_launch(void* const* d_in, const int* in_sizes, int n_in, void* d_out, int out_size, void* d_ws, size_t ws_size, hipStream_t stream) {
    static int grid = 0;
    if (grid == 0) {
        if (n_in != 19 || out_size != M * D || ws_size < WS_END) { fprintf(stderr, "kernel_launch: unexpected shapes (n_in %d, out %d, ws %zu)\n", n_in, out_size, ws_size); grid = -1; return; }
        int dev = 0, cus = 0, per_cu = 0;
        if (hipGetDevice(&dev) != hipSuccess || hipDeviceGetAttribute(&cus, hipDeviceAttributeMultiprocessorCount, dev) != hipSuccess) { grid = -1; return; }
        if (hipFuncSetAttribute((const void*)fwd_kernel, hipFuncAttributeMaxDynamicSharedMemorySize, LDS_BYTES) != hipSuccess) { fprintf(stderr, "kernel_launch: hipFuncSetAttribute failed\n"); grid = -1; return; }
        if (hipOccupancyMaxActiveBlocksPerMultiprocessor(&per_cu, (const void*)fwd_kernel, NTHR, LDS_BYTES) != hipSuccess || per_cu < 1) { fprintf(stderr, "kernel_launch: occupancy query says %d\n", per_cu); (void)hipGetLastError(); per_cu = 1; }
        grid = cus * per_cu;
        fprintf(stderr, "kernel_launch: grid %d (cus %d x %d)\n", grid, cus, per_cu);
    }
    if (grid < 0) return;
    Args a{};
    for (int i = 0; i < 19; ++i) a.in[i] = (const float*)d_in[i];
    a.out = (float*)d_out; a.ws = (unsigned char*)d_ws;
#if MK_ONE_LAUNCH
    a.ph_lo = 0; a.ph_hi = NPHASES;
    void* kargs[] = {&a};
    hipError_t e = hipLaunchCooperativeKernel((const void*)fwd_kernel, dim3(grid), dim3(NTHR), kargs, LDS_BYTES, stream);
    if (e != hipSuccess) fprintf(stderr, "kernel_launch: cooperative launch failed: %s (grid %d)\n", hipGetErrorString(e), grid);
#else
    for (int ph = 0; ph < NPHASES; ++ph) {
        a.ph_lo = ph; a.ph_hi = ph + 1;
        hipLaunchKernelGGL(fwd_kernel, dim3(grid), dim3(NTHR), LDS_BYTES, stream, a);
    }
#endif
}
```
